# Optimizing an MI355X kernel written in HIP

```python
import math
import jax, jax.numpy as jnp
from jax import lax
import numpy as np

D_MODEL = 1024
BATCH = 8
SEQ = 2048
DEPTH = 1

D_FF = 2816
F_GROUPS = 4
F_GROUP_CH = 128
F_WIDTH = F_GROUPS * F_GROUP_CH
DA_HEADS = 4
DA_HEAD_DIM = 64
DA_V_DIM = 2 * DA_HEAD_DIM
QK_WIDTH = DA_HEADS * 2 * DA_HEAD_DIM
V_WIDTH = DA_HEADS * DA_V_DIM
GATE_WIDTH = 2 * D_MODEL
IN_WIDTH = F_WIDTH + 2 * QK_WIDTH + V_WIDTH + GATE_WIDTH
REL_BUCKETS = 32
REL_MAX_DIST = 128
Q_BLOCK = 128
NORM_EPS = 1e-6
SUBLN_EPS = 1e-5

kernel_name = "hybrid_fnet_diffattn_macaron_encoder"


def rms_norm(x, g, eps=NORM_EPS):
    xf = x.astype(jnp.float32)
    y = xf * lax.rsqrt(jnp.mean(xf * xf, axis=-1, keepdims=True) + eps)
    return (y * g.astype(jnp.float32)).astype(x.dtype)


def swiglu(x, wg, wu, wd):
    return (jax.nn.silu(x @ wg) * (x @ wu)) @ wd


def t5_bidirectional_bucket(rel):
    nb = REL_BUCKETS // 2
    max_exact = nb // 2
    ret = (rel > 0).astype(jnp.int32) * nb
    n = jnp.abs(rel)
    nf = jnp.maximum(n, 1).astype(jnp.float32)
    large = max_exact + (jnp.log(nf / max_exact) / math.log(REL_MAX_DIST / max_exact)
                         * (nb - max_exact)).astype(jnp.int32)
    large = jnp.minimum(large, nb - 1)
    return ret + jnp.where(n < max_exact, n, large)


def fourier_branch(u_f):
    B, S, _ = u_f.shape
    uf = u_f.reshape(B, S, F_GROUPS, F_GROUP_CH).astype(jnp.float32)
    y = jnp.fft.fft2(uf, axes=(1, 3), norm="ortho").real
    return y.astype(u_f.dtype).reshape(B, S, F_WIDTH)


def diff_attention(q, k, v, positions, rel_bias, lam):
    B, S = q.shape[0], q.shape[1]
    nb = S // Q_BLOCK
    scale = DA_HEAD_DIM ** -0.5
    q = jnp.transpose(q, (3, 0, 2, 1, 4))
    k = jnp.transpose(k, (3, 0, 2, 1, 4))
    vh = jnp.transpose(v, (0, 2, 1, 3))
    qb = q.reshape(2, B, DA_HEADS, nb, Q_BLOCK, DA_HEAD_DIM)
    qb = jnp.moveaxis(qb, 3, 0)
    pb = jnp.moveaxis(positions.reshape(B, nb, Q_BLOCK), 1, 0)

    def block(args):
        qblk, pblk = args
        rel = positions[:, None, :] - pblk[:, :, None]
        bias = rel_bias[t5_bidirectional_bucket(rel)]
        bias = jnp.transpose(bias, (0, 3, 1, 2)).astype(jnp.float32)
        s1 = jnp.einsum('bhqd,bhkd->bhqk', qblk[0], k[0]).astype(jnp.float32) * scale + bias
        s2 = jnp.einsum('bhqd,bhkd->bhqk', qblk[1], k[1]).astype(jnp.float32) * scale + bias
        attn = jax.nn.softmax(s1, axis=-1) - lam * jax.nn.softmax(s2, axis=-1)
        return jnp.einsum('bhqk,bhkv->bhqv', attn.astype(vh.dtype), vh)

    out = lax.map(block, (qb, pb))
    out = jnp.transpose(out, (1, 0, 3, 2, 4))
    return out.reshape(B, S, DA_HEADS, DA_V_DIM)


def hybrid_mixer(h, positions, rel_bias, w_in, lq1, lk1, lq2, lk2, subln_g,
                 w_fourier_out, w_attn_out, w_out, layer_idx):
    B, S, _ = h.shape
    proj = h @ w_in
    cuts = np.cumsum([F_WIDTH, QK_WIDTH, QK_WIDTH, V_WIDTH, D_MODEL]).tolist()
    u_f, q, k, v, g_a, g_b = jnp.split(proj, cuts, axis=-1)

    y_a = fourier_branch(u_f) @ w_fourier_out

    lambda_init = 0.8 - 0.6 * math.exp(-0.3 * layer_idx)
    lam = (jnp.exp(jnp.sum(lq1.astype(jnp.float32) * lk1.astype(jnp.float32)))
           - jnp.exp(jnp.sum(lq2.astype(jnp.float32) * lk2.astype(jnp.float32)))
           + lambda_init)
    q = q.reshape(B, S, DA_HEADS, 2, DA_HEAD_DIM)
    k = k.reshape(B, S, DA_HEADS, 2, DA_HEAD_DIM)
    v = v.reshape(B, S, DA_HEADS, DA_V_DIM)
    o = diff_attention(q, k, v, positions, rel_bias, lam)
    o = rms_norm(o, subln_g, SUBLN_EPS) * (1.0 - lambda_init)
    y_b = o.reshape(B, S, V_WIDTH) @ w_attn_out

    merged = jax.nn.sigmoid(g_a) * y_a + jax.nn.sigmoid(g_b) * y_b
    return merged @ w_out


def setup_inputs(seed: int = 0) -> dict:
    key = jax.random.key(seed)
    ks = jax.random.split(key, 24)
    L, D = DEPTH, D_MODEL
    nrm = lambda k, shape, fan_in: jax.random.normal(k, shape, jnp.float32) * fan_in ** -0.5
    gain = lambda k, shape: 1.0 + 0.02 * jax.random.normal(k, shape, jnp.float32)
    return {
        "x": jax.random.normal(ks[0], (BATCH, SEQ, D), jnp.float32),
        "positions": jnp.broadcast_to(jnp.arange(SEQ, dtype=jnp.int32), (BATCH, SEQ)),
        "rel_bias": 0.1 * jax.random.normal(ks[1], (REL_BUCKETS, DA_HEADS), jnp.float32),
        "ffn1_norm": gain(ks[2], (L, D)),
        "ffn1_wg": nrm(ks[3], (L, D, D_FF), D),
        "ffn1_wu": nrm(ks[4], (L, D, D_FF), D),
        "ffn1_wd": nrm(ks[5], (L, D_FF, D), D_FF),
        "mix_norm": gain(ks[6], (L, D)),
        "w_in": nrm(ks[7], (L, D, IN_WIDTH), D),
        "lambda_q1": 0.1 * jax.random.normal(ks[8], (L, DA_HEAD_DIM), jnp.float32),
        "lambda_k1": 0.1 * jax.random.normal(ks[9], (L, DA_HEAD_DIM), jnp.float32),
        "lambda_q2": 0.1 * jax.random.normal(ks[10], (L, DA_HEAD_DIM), jnp.float32),
        "lambda_k2": 0.1 * jax.random.normal(ks[11], (L, DA_HEAD_DIM), jnp.float32),
        "subln_g": gain(ks[12], (L, DA_V_DIM)),
        "w_fourier_out": nrm(ks[13], (L, F_WIDTH, D), F_WIDTH),
        "w_attn_out": nrm(ks[14], (L, V_WIDTH, D), V_WIDTH),
        "w_out": nrm(ks[15], (L, D, D), D),
        "ffn2_norm": gain(ks[16], (L, D)),
        "ffn2_wg": nrm(ks[17], (L, D, D_FF), D),
        "ffn2_wu": nrm(ks[18], (L, D, D_FF), D),
        "ffn2_wd": nrm(ks[19], (L, D_FF, D), D_FF),
        "final_norm": gain(ks[20], (D,)),
    }


def reference(x, positions, rel_bias, ffn1_norm, ffn1_wg, ffn1_wu, ffn1_wd,
              mix_norm, w_in, lambda_q1, lambda_k1, lambda_q2, lambda_k2, subln_g,
              w_fourier_out, w_attn_out, w_out, ffn2_norm, ffn2_wg, ffn2_wu,
              ffn2_wd, final_norm):
    for l in range(DEPTH):
        x = x + 0.5 * swiglu(rms_norm(x, ffn1_norm[l]), ffn1_wg[l], ffn1_wu[l], ffn1_wd[l])
        x = x + hybrid_mixer(rms_norm(x, mix_norm[l]), positions, rel_bias, w_in[l],
                             lambda_q1[l], lambda_k1[l], lambda_q2[l], lambda_k2[l],
                             subln_g[l], w_fourier_out[l], w_attn_out[l], w_out[l], l)
        x = x + 0.5 * swiglu(rms_norm(x, ffn2_norm[l]), ffn2_wg[l], ffn2_wu[l], ffn2_wd[l])
    return rms_norm(x, final_norm)
```

```cpp
#include <hip/hip_runtime.h>
#include <hip/hip_bf16.h>
#include <cstdio>
#include <cstdint>
#include <cmath>

constexpr int BATCH = 8, SEQ = 2048, D = 1024, M = BATCH * SEQ, FF = 2816, INW = 4096;
constexpr int NH = 4, HD = 64, VD = 128, FW = 512;
constexpr float NORM_EPS = 1e-6f, SUBLN_EPS = 1e-5f, LAMBDA_INIT = 0.2f;
constexpr float LOG2E = 1.4426950408889634f;
constexpr float QSCALE = 0.125f * LOG2E;
namespace pg8 {
#define PG8_LAS __attribute__((address_space(3)))
typedef unsigned short bf16_t;
typedef short bf16x8 __attribute__((ext_vector_type(8)));
typedef float f32x4 __attribute__((ext_vector_type(4)));
typedef unsigned u32x4 __attribute__((ext_vector_type(4)));
constexpr int BM = 256, BK = 64, HALF = 128, HTB = HALF * BK * 2  , STAGE_BYTES = 8 * HTB, NXCD = 8, WGM = 8;

__host__ __device__ __forceinline__ int lds_byte(int r, int c) { const int st = (r >> 4) * 2 + (c >> 5), rr = r & 15, cc = c & 31, ob = rr * 64 + cc * 2; return st * 1024 + (ob ^ (((ob >> 9) & 1) << 5)); }
__host__ __device__ __forceinline__ void stage_rc(int b, int& R, int& C) { const int st = b / 1024, sb = b % 1024, swz = sb ^ (((sb >> 9) & 1) << 5); R = (st >> 1) * 16 + swz / 64; C = (st & 1) * 32 + (swz % 64) / 2; }
__host__ __device__ __forceinline__ int perm32(int rho) { const int n = rho >> 4, i = rho & 15; return 8 * (i >> 2) + 4 * n + (i & 3); }

struct Unit { int pm, pn; };
struct Gemm { const bf16_t* A; const bf16_t* Bt; int M, N, K; };

struct StaticOrder {
    int nM, nN, nwg, G, c;
    __host__ __device__ void init(int M, int N, int G_, int c_) { nM = M / BM; nN = N / BM; nwg = nM * nN; G = G_; c = c_; }
    __host__ __device__ bool next(int i, Unit& u) const {
        const long L = (long)i * G + c; if (L >= nwg) return false;
        int wgid = (int)L; { const int q = nwg / NXCD, r = nwg % NXCD, xcd = wgid % NXCD, off = wgid / NXCD; wgid = (xcd < r ? xcd * (q + 1) : r * (q + 1) + (xcd - r) * q) + off; }
        const int nig = WGM * nN, gid = wgid / nig, fm = gid * WGM, gsz = (nM - fm) < WGM ? (nM - fm) : WGM;
        u.pm = fm + ((wgid % nig) % gsz); u.pn = (wgid % nig) / gsz; return true;
    }
    __device__ __forceinline__ void a_ready(const Unit&) const {}
    __device__ __forceinline__ void done(const Unit&) const {}
};


__device__ __forceinline__ unsigned cvt_pk_bf16(float lo, float hi) { unsigned r; asm volatile("v_cvt_pk_bf16_f32 %0, %1, %2" : "=v"(r) : "v"(lo), "v"(hi)); return r; }
typedef unsigned u32x2 __attribute__((ext_vector_type(2)));
__device__ __forceinline__ float bf_lo(unsigned w) { return __uint_as_float(w << 16); }
__device__ __forceinline__ float bf_hi(unsigned w) { return __uint_as_float(w & 0xffff0000u); }
__device__ __forceinline__ unsigned short f2bf_s(float f) { unsigned u = __builtin_bit_cast(unsigned, f); return (unsigned short)((u + 0x7fffu + ((u >> 16) & 1u)) >> 16); }
__device__ __forceinline__ u32x4 pack8(const f32x4& a, const f32x4& b) { u32x4 w; w.x = cvt_pk_bf16(a[0], a[1]); w.y = cvt_pk_bf16(a[2], a[3]); w.z = cvt_pk_bf16(b[0], b[1]); w.w = cvt_pk_bf16(b[2], b[3]); return w; }
__device__ __forceinline__ float rstd_row(const float* ssq4, int row) { const f32x4 s = *(const f32x4*)(ssq4 + (size_t)row * 4); return rsqrtf(((s[0] + s[1]) + (s[2] + s[3])) * (1.0f / 1024.0f) + 1e-6f); }
__device__ __forceinline__ float silu1(float x) { return x * __builtin_amdgcn_rcpf(1.0f + __builtin_amdgcn_exp2f(-1.4426950408889634f * x)); }
__device__ __forceinline__ float sigm1(float x) { return __builtin_amdgcn_rcpf(1.0f + __builtin_amdgcn_exp2f(-1.4426950408889634f * x)); }

struct EpiSwiglu {
    static constexpr bool PERM = true, AFTER_DRAIN = false;
    bf16_t* H; const float* ssq4; int ldh;
    __device__ __forceinline__ void operator()(const f32x4 (&acc)[2][2][4][2], const Unit& u, int wr, int wc, int fr, int fq) const {
        const int row0 = u.pm * BM + wr * 64 + fr, col0 = u.pn * HALF + wc * 32 + 8 * fq;
#pragma unroll
        for (int ai = 0; ai < 2; ++ai)
#pragma unroll
            for (int m = 0; m < 4; ++m) { const int row = row0 + ai * HALF + m * 16; const float rs = rstd_row(ssq4, row);
                f32x4 h0, h1;
#pragma unroll
                for (int e = 0; e < 4; ++e) { h0[e] = silu1(acc[ai][0][m][0][e] * rs) * (acc[ai][1][m][0][e] * rs); h1[e] = silu1(acc[ai][0][m][1][e] * rs) * (acc[ai][1][m][1][e] * rs); }
                *(u32x4*)(H + (size_t)row * ldh + col0) = pack8(h0, h1); }
    }
};

struct EpiResid {
    static constexpr bool PERM = false, AFTER_DRAIN = true;
    const float* base; float* out; bf16_t* xb; float* ssq4; float alpha; int ldc;
    __device__ __forceinline__ void fused(f32x4 (&acc)[2][2][4][2], const Unit& u, int wr, int wc, int fr, int fq, PG8_LAS unsigned char* lds, int wid, int lane) const {
        PG8_LAS float* P = (PG8_LAS float*)lds;
        const int col0 = u.pn * BM + wc * 32 + 4 * fq;
#pragma unroll
        for (int ai = 0; ai < 2; ++ai)
#pragma unroll
            for (int m = 0; m < 4; ++m) { const int r = ai * HALF + wr * 64 + m * 16 + fr; const size_t off = (size_t)(u.pm * BM + r) * ldc + col0; float s = 0.f;
#pragma unroll
                for (int bj = 0; bj < 2; ++bj)
#pragma unroll
                    for (int n = 0; n < 2; ++n) { const f32x4 b = *(const f32x4*)(base + off + bj * HALF + n * 16); const f32x4 v = b + acc[ai][bj][m][n] * alpha;
                        *(f32x4*)(out + off + bj * HALF + n * 16) = v; s += (v[0] * v[0] + v[1] * v[1]) + (v[2] * v[2] + v[3] * v[3]);
                        if (xb) { u32x2 w; w.x = cvt_pk_bf16(v[0], v[1]); w.y = cvt_pk_bf16(v[2], v[3]); *(u32x2*)(xb + off + bj * HALF + n * 16) = w; } }
                s += __shfl_xor(s, 16); s += __shfl_xor(s, 32);
                if (fq == 0) P[r * 4 + wc] = s;
                if (m & 1) asm volatile("" ::: "memory"); }
        asm volatile("s_waitcnt lgkmcnt(0)" ::: "memory"); __builtin_amdgcn_s_barrier(); asm volatile("" ::: "memory");
        const int tid = wid * 64 + lane;
        if (tid < 256) { const PG8_LAS f32x4* p4 = (const PG8_LAS f32x4*)P; const f32x4 p = p4[tid]; ssq4[(size_t)(u.pm * BM + tid) * 4 + u.pn] = (p[0] + p[1]) + (p[2] + p[3]); }
    }
};

struct EpiWin {
    static constexpr bool PERM = true, AFTER_DRAIN = false;
    const float* ssq4; bf16_t *UT, *QKV, *GAB; float qscale;
    __device__ __forceinline__ void operator()(const f32x4 (&acc)[2][2][4][2], const Unit& u, int wr, int wc, int fr, int fq) const {
        const int row0 = u.pm * BM + wr * 64 + fr, cl = wc * 32 + 8 * fq, pn = u.pn;
        if (pn < 2) {
            const int b = u.pm >> 3, s0 = (u.pm & 7) * BM + wr * 64 + fr;
#pragma unroll
            for (int ai = 0; ai < 2; ++ai)
#pragma unroll
                for (int m = 0; m < 4; ++m) { const float rs = rstd_row(ssq4, row0 + ai * HALF + m * 16); const int s = s0 + ai * HALF + m * 16;
#pragma unroll
                    for (int bj = 0; bj < 2; ++bj)
#pragma unroll
                        for (int n = 0; n < 2; ++n)
#pragma unroll
                            for (int e = 0; e < 4; ++e) { const int c = pn * BM + bj * HALF + cl + 4 * n + e; UT[((size_t)(b * 512 + c)) * 2048 + s] = f2bf_s(acc[ai][bj][m][n][e] * rs); } }
        } else if (pn < 8) {
            bf16_t* dst = QKV + (size_t)((pn - 2) >> 1) * (8u << 20); const int cb = (pn & 1) * BM + cl; const float sc = pn < 4 ? qscale : 1.0f;
#pragma unroll
            for (int ai = 0; ai < 2; ++ai)
#pragma unroll
                for (int m = 0; m < 4; ++m) { const int row = row0 + ai * HALF + m * 16; const float rs = rstd_row(ssq4, row) * sc;
#pragma unroll
                    for (int bj = 0; bj < 2; ++bj) *(u32x4*)(dst + (size_t)row * 512 + cb + bj * HALF) = pack8(acc[ai][bj][m][0] * rs, acc[ai][bj][m][1] * rs); }
        } else {
            bf16_t* dst = GAB + (size_t)((pn - 8) >> 2) * (16u << 20); const int cb = ((pn - 8) & 3) * BM + cl;
#pragma unroll
            for (int ai = 0; ai < 2; ++ai)
#pragma unroll
                for (int m = 0; m < 4; ++m) { const int row = row0 + ai * HALF + m * 16; const float rs = rstd_row(ssq4, row);
#pragma unroll
                    for (int bj = 0; bj < 2; ++bj) { f32x4 a, b2;
#pragma unroll
                        for (int e = 0; e < 4; ++e) { a[e] = sigm1(acc[ai][bj][m][0][e] * rs); b2[e] = sigm1(acc[ai][bj][m][1][e] * rs); }
                        *(u32x4*)(dst + (size_t)row * 1024 + cb + bj * HALF) = pack8(a, b2); } }
        }
    }
};

struct EpiDft {
    static constexpr bool PERM = true, AFTER_DRAIN = false;
    bf16_t* PQ;
    __device__ __forceinline__ void operator()(const f32x4 (&acc)[2][2][4][2], const Unit& u, int wr, int wc, int fr, int fq) const {
        const int b = u.pn >> 1, row0 = b * 2048 + (u.pm & 7) * BM + wr * 64 + fr, col0 = (u.pm >> 3) * 512 + (u.pn & 1) * BM + wc * 32 + 8 * fq;
#pragma unroll
        for (int ai = 0; ai < 2; ++ai)
#pragma unroll
            for (int m = 0; m < 4; ++m) { const int row = row0 + ai * HALF + m * 16;
#pragma unroll
                for (int bj = 0; bj < 2; ++bj) *(u32x4*)(PQ + (size_t)row * 1024 + col0 + bj * HALF) = pack8(acc[ai][bj][m][0], acc[ai][bj][m][1]); }
    }
};

struct EpiGateA {
    static constexpr bool PERM = true, AFTER_DRAIN = false;
    const bf16_t* GA; float* TMP;
    __device__ __forceinline__ void operator()(const f32x4 (&acc)[2][2][4][2], const Unit& u, int wr, int wc, int fr, int fq) const {
        const int row0 = u.pm * BM + wr * 64 + fr, col0 = u.pn * BM + wc * 32 + 8 * fq;
#pragma unroll
        for (int ai = 0; ai < 2; ++ai)
#pragma unroll
            for (int m = 0; m < 4; ++m) { const int row = row0 + ai * HALF + m * 16;
#pragma unroll
                for (int bj = 0; bj < 2; ++bj) { const size_t off = (size_t)row * 1024 + col0 + bj * HALF; const u32x4 g = *(const u32x4*)(GA + off);
                    const f32x4 g0 = {bf_lo(g.x), bf_hi(g.x), bf_lo(g.y), bf_hi(g.y)}, g1 = {bf_lo(g.z), bf_hi(g.z), bf_lo(g.w), bf_hi(g.w)};
                    *(f32x4*)(TMP + off) = acc[ai][bj][m][0] * g0; *(f32x4*)(TMP + off + 4) = acc[ai][bj][m][1] * g1; } }
    }
};
struct EpiGateB {
    static constexpr bool PERM = true, AFTER_DRAIN = false;
    bf16_t* GB; const float* TMP;
    __device__ __forceinline__ void operator()(const f32x4 (&acc)[2][2][4][2], const Unit& u, int wr, int wc, int fr, int fq) const {
        const int row0 = u.pm * BM + wr * 64 + fr, col0 = u.pn * BM + wc * 32 + 8 * fq;
#pragma unroll
        for (int ai = 0; ai < 2; ++ai)
#pragma unroll
            for (int m = 0; m < 4; ++m) { const int row = row0 + ai * HALF + m * 16;
#pragma unroll
                for (int bj = 0; bj < 2; ++bj) { const size_t off = (size_t)row * 1024 + col0 + bj * HALF; const u32x4 g = *(const u32x4*)(GB + off);
                    const f32x4 t0 = *(const f32x4*)(TMP + off), t1 = *(const f32x4*)(TMP + off + 4);
                    const f32x4 g0 = {bf_lo(g.x), bf_hi(g.x), bf_lo(g.y), bf_hi(g.y)}, g1 = {bf_lo(g.z), bf_hi(g.z), bf_lo(g.w), bf_hi(g.w)};
                    *(u32x4*)(GB + off) = pack8(t0 + acc[ai][bj][m][0] * g0, t1 + acc[ai][bj][m][1] * g1); } }
    }
};
struct DftOrder {
    int c;
    __device__ __forceinline__ bool next(int i, Unit& u) const { if (i != 0 || c >= 256) return false; u.pm = c & 15; u.pn = c >> 4; return true; }
    __device__ __forceinline__ void a_ready(const Unit&) const {}
    __device__ __forceinline__ void done(const Unit&) const {}
};
template <class Epi, class Sched, bool ALIGN_EPI = false, bool SP2 = false>
__device__ __forceinline__ void gemm_phase(PG8_LAS unsigned char* lds, const Gemm g, const Sched& S, const Epi& E) {
    int tid_l = threadIdx.x; asm volatile("" : "+v"(tid_l));
    const int tid = tid_l, wid = __builtin_amdgcn_readfirstlane(tid >> 6), lane = tid & 63, wr = wid >> 2, wc = wid & 3, fr = lane & 15, fq = lane >> 4;
    const int K = g.K, nt = K / BK;
    unsigned voffA[2], voffB[2];
#pragma unroll
    for (int i = 0; i < 2; ++i) { int R, C; stage_rc(tid * 16 + i * 8192, R, C); const int Rb = Epi::PERM ? ((R & ~31) + perm32(R & 31)) : R;
        voffA[i] = (unsigned)(R * K + C) * 2u; voffB[i] = (unsigned)(Rb * K + C) * 2u; }
    const size_t kstep = (size_t)(BK * 2);
    const size_t hstep = (size_t)HALF * K * 2;
    const size_t tstep = 2 * hstep;
    const unsigned ldsw = (unsigned)wid * 1024u;
    const int aoff = lds_byte(wr * 64 + fr, fq * 8), boff = lds_byte(wc * 32 + fr, fq * 8);
#define PG8_SA(b, h) (((b) * 2 + (h)) * HTB)
#define PG8_SB(b, h) ((4 + (b) * 2 + (h)) * HTB)
#define PG8_STAGE(bufoff, gbase, voff) do { _Pragma("unroll") for (int _i = 0; _i < 2; ++_i) \
        __builtin_amdgcn_global_load_lds((const unsigned*)((const char*)(gbase) + (voff)[_i]), (PG8_LAS unsigned*)(lds + (bufoff) + ldsw + _i * 8192), 16, 0, 0); } while (0)
#define PG8_LDA(dst, b, h) do { _Pragma("unroll") for (int m = 0; m < 4; ++m) _Pragma("unroll") for (int k = 0; k < 2; ++k) dst[m][k] = *(const PG8_LAS bf16x8*)(lds + PG8_SA(b, h) + aoff + m * 2048 + k * 1024); } while (0)
#define PG8_LDB(dst, b, h) do { _Pragma("unroll") for (int n = 0; n < 2; ++n) _Pragma("unroll") for (int k = 0; k < 2; ++k) dst[n][k] = *(const PG8_LAS bf16x8*)(lds + PG8_SB(b, h) + boff + n * 2048 + k * 1024); } while (0)
#define PG8_MMA(ai, bj, At, Bt) do { __builtin_amdgcn_s_setprio(1); _Pragma("unroll") for (int m = 0; m < 4; ++m) _Pragma("unroll") for (int n = 0; n < 2; ++n) _Pragma("unroll") for (int k = 0; k < 2; ++k) \
        acc[ai][bj][m][n] = __builtin_amdgcn_mfma_f32_16x16x32_bf16(Bt[n][k], At[m][k], acc[ai][bj][m][n], 0, 0, 0); __builtin_amdgcn_s_setprio(0); } while (0)
#define PG8_WAIT_V(n) asm volatile("s_waitcnt vmcnt(" #n ")" ::: "memory")
#define PG8_WAIT_L(n) asm volatile("s_waitcnt lgkmcnt(" #n ")" ::: "memory")
#define PG8_BAR __builtin_amdgcn_s_barrier()
#define PG8_SCHED __builtin_amdgcn_sched_barrier(0)
    Unit cur, nxt; int ui = 0;
    if (!S.next(0, cur)) return;
    f32x4 acc[2][2][4][2];
#pragma unroll
    for (int a = 0; a < 2; ++a)
#pragma unroll
        for (int b = 0; b < 2; ++b)
#pragma unroll
            for (int m = 0; m < 4; ++m)
#pragma unroll
                for (int n = 0; n < 2; ++n) acc[a][b][m][n] = (f32x4){0.f, 0.f, 0.f, 0.f};
    bf16x8 At[4][2], B0[2][2], B1[2][2];
    const char* cA = (const char*)g.A + (size_t)cur.pm * tstep; const char* cB = (const char*)g.Bt + (size_t)cur.pn * tstep;
    S.a_ready(cur);
    if constexpr (SP2) {
        PG8_STAGE(PG8_SB(0, 0), cB, voffB); PG8_STAGE(PG8_SB(0, 1), cB + hstep, voffB); PG8_STAGE(PG8_SA(0, 0), cA, voffA); PG8_STAGE(PG8_SA(0, 1), cA + hstep, voffA);
        if (wr == 1) PG8_BAR;
        PG8_WAIT_V(2); PG8_BAR;
        PG8_STAGE(PG8_SB(1, 0), cB + kstep, voffB); PG8_STAGE(PG8_SA(1, 0), cA + kstep, voffA); PG8_STAGE(PG8_SB(1, 1), cB + hstep + kstep, voffB);
        PG8_WAIT_V(6); PG8_BAR;
    } else {
        PG8_STAGE(PG8_SB(0, 0), cB, voffB); PG8_STAGE(PG8_SA(0, 0), cA, voffA); PG8_STAGE(PG8_SB(0, 1), cB + hstep, voffB); PG8_STAGE(PG8_SA(0, 1), cA + hstep, voffA);
        if (wr == 1) PG8_BAR;
        PG8_WAIT_V(4); PG8_BAR;
        PG8_STAGE(PG8_SB(1, 0), cB + kstep, voffB); PG8_STAGE(PG8_SA(1, 0), cA + kstep, voffA); PG8_STAGE(PG8_SB(1, 1), cB + hstep + kstep, voffB);
        PG8_WAIT_V(6); PG8_BAR;
    }
    for (;;) {
        const bool has_next = S.next(ui + 1, nxt);
        const char* nA = has_next ? (const char*)g.A + (size_t)nxt.pm * tstep : cA; const char* nB = has_next ? (const char*)g.Bt + (size_t)nxt.pn * tstep : cB;
        for (int t = 0; t < nt; t += 2) {
            const bool last = (t == nt - 2);
            const char* a1 = cA + (size_t)(t + 1) * kstep;
            const char* a2 = last ? nA : cA + (size_t)(t + 2) * kstep; const char* b2 = last ? nB : cB + (size_t)(t + 2) * kstep;
            const char* a3 = a2 + kstep; const char* b3 = b2 + kstep;
            if (last && has_next) S.a_ready(nxt);
            if constexpr (SP2) {
            PG8_LDB(B0, 0, 0); PG8_LDB(B1, 0, 1); PG8_SCHED; PG8_LDA(At, 0, 0); PG8_STAGE(PG8_SA(1, 1), a1 + hstep, voffA);
            PG8_WAIT_V(8); PG8_WAIT_L(0); PG8_BAR; PG8_MMA(0, 0, At, B0); PG8_MMA(0, 1, At, B1); PG8_BAR; PG8_SCHED;
            PG8_LDA(At, 0, 1); PG8_STAGE(PG8_SB(0, 0), b2, voffB); PG8_STAGE(PG8_SB(0, 1), b2 + hstep, voffB); PG8_STAGE(PG8_SA(0, 0), a2, voffA);
            PG8_WAIT_V(8); PG8_WAIT_L(0); PG8_BAR; PG8_MMA(1, 0, At, B0); PG8_MMA(1, 1, At, B1); PG8_BAR; PG8_SCHED;
            PG8_LDB(B0, 1, 0); PG8_LDB(B1, 1, 1); PG8_SCHED; PG8_LDA(At, 1, 0); PG8_STAGE(PG8_SA(0, 1), a2 + hstep, voffA);
            PG8_WAIT_V(8); PG8_WAIT_L(0); PG8_BAR; PG8_MMA(0, 0, At, B0); PG8_MMA(0, 1, At, B1); PG8_BAR; PG8_SCHED;
            PG8_LDA(At, 1, 1); PG8_STAGE(PG8_SB(1, 0), b3, voffB); PG8_STAGE(PG8_SB(1, 1), b3 + hstep, voffB); PG8_STAGE(PG8_SA(1, 0), a3, voffA);
            PG8_WAIT_V(8); PG8_WAIT_L(0); PG8_BAR; PG8_MMA(1, 0, At, B0); PG8_MMA(1, 1, At, B1); PG8_BAR; PG8_SCHED;
            } else {
            PG8_LDB(B0, 0, 0); PG8_SCHED; PG8_LDA(At, 0, 0); PG8_STAGE(PG8_SA(1, 1), a1 + hstep, voffA);
            PG8_WAIT_L(8); PG8_BAR; PG8_WAIT_L(0); PG8_MMA(0, 0, At, B0); PG8_BAR; PG8_SCHED;
            PG8_LDB(B1, 0, 1); PG8_STAGE(PG8_SB(0, 0), b2, voffB);
            PG8_BAR; PG8_WAIT_L(0); PG8_MMA(0, 1, At, B1); PG8_BAR;
            PG8_LDA(At, 0, 1); PG8_STAGE(PG8_SA(0, 0), a2, voffA);
            PG8_BAR; PG8_WAIT_L(0); PG8_MMA(1, 0, At, B0); PG8_BAR; PG8_SCHED;
            PG8_STAGE(PG8_SB(0, 1), b2 + hstep, voffB);
            PG8_WAIT_V(6); PG8_BAR; PG8_MMA(1, 1, At, B1); PG8_BAR;
            PG8_LDB(B0, 1, 0); PG8_SCHED; PG8_LDA(At, 1, 0); PG8_STAGE(PG8_SA(0, 1), a2 + hstep, voffA);
            PG8_WAIT_L(8); PG8_BAR; PG8_WAIT_L(0); PG8_MMA(0, 0, At, B0); PG8_BAR; PG8_SCHED;
            PG8_LDB(B1, 1, 1); PG8_STAGE(PG8_SB(1, 0), b3, voffB);
            PG8_BAR; PG8_WAIT_L(0); PG8_MMA(0, 1, At, B1); PG8_BAR;
            PG8_LDA(At, 1, 1); PG8_STAGE(PG8_SA(1, 0), a3, voffA);
            PG8_BAR; PG8_WAIT_L(0); PG8_MMA(1, 0, At, B0); PG8_BAR; PG8_SCHED;
            PG8_STAGE(PG8_SB(1, 1), b3 + hstep, voffB);
            PG8_WAIT_V(6); PG8_BAR; PG8_MMA(1, 1, At, B1); PG8_BAR;
            }
        }
        if constexpr (ALIGN_EPI) { if (wr == 0) PG8_BAR; }
        if constexpr (!Epi::AFTER_DRAIN) { E(acc, cur, wr, wc, fr, fq); S.done(cur); }
        if (!has_next) break;
#pragma unroll
        for (int a = 0; a < 2; ++a)
#pragma unroll
            for (int b = 0; b < 2; ++b)
#pragma unroll
                for (int m = 0; m < 4; ++m)
#pragma unroll
                    for (int n = 0; n < 2; ++n) acc[a][b][m][n] = (f32x4){0.f, 0.f, 0.f, 0.f};
        cur = nxt; cA = nA; cB = nB; ++ui;
        if constexpr (ALIGN_EPI) { if (wr == 1) PG8_BAR; }
    }
    PG8_WAIT_V(0);
    if constexpr (!ALIGN_EPI) { if (wr == 0) PG8_BAR; }
    PG8_BAR;
    if constexpr (Epi::AFTER_DRAIN) { E.fused(acc, cur, wr, wc, fr, fq, lds, wid, lane); S.done(cur); }
#undef PG8_SA
#undef PG8_SB
#undef PG8_STAGE
#undef PG8_LDA
#undef PG8_LDB
#undef PG8_MMA
#undef PG8_WAIT_V
#undef PG8_WAIT_L
#undef PG8_BAR
#undef PG8_SCHED
}
}

namespace att {
using bf16x8 = __attribute__((ext_vector_type(8))) short;
using s16x4  = __attribute__((ext_vector_type(4))) short;
using f32x16 = __attribute__((ext_vector_type(16))) float;
using u32x4  = __attribute__((ext_vector_type(4))) unsigned;
using i32x4  = __attribute__((ext_vector_type(4))) int;
typedef unsigned short bf16_t;
constexpr int NW = 8, QBLK = 32, KVBLK = 64, NT = SEQ / KVBLK, LDP = 512;
#ifndef ATT_SDEPTH
#define ATT_SDEPTH 1
#endif
constexpr int SDEPTH = ATT_SDEPTH;
constexpr float THR = 8.f;
constexpr int SHM_V = KVBLK * VD * 2, SHM_K = KVBLK * HD * 2;
constexpr int L_V = 0, L_K = 2 * SHM_V, L_WS = L_K + 2 * SHM_K, L_ST = L_WS + NW * 256, L_KP = L_ST + NW * 8192, L_LUT = L_KP + SEQ * 4, L_MM = L_LUT + 1280, L_END = L_MM + 256;
static_assert(L_END <= 131072, "attention LDS map");
#define ATT_KS(row, ch) ((row) * 128 + ((((ch) ^ (((row) >> 1) & 7))) << 4))
#define ATT_SBAR() __builtin_amdgcn_sched_barrier(0)
__device__ __forceinline__ int crow(int r, int hi) { return (r & 3) + 8 * (r >> 2) + 4 * hi; }
__device__ __forceinline__ unsigned cvtpk(float lo, float hi) { unsigned r; asm volatile("v_cvt_pk_bf16_f32 %0, %1, %2" : "=v"(r) : "v"(lo), "v"(hi)); return r; }

__device__ __forceinline__ void partialSM(f32x16& p0, f32x16& p1, float c, float& m_reg, float& alpha) {
  float pmax = p0[0];
#pragma unroll
  for (int r = 1; r < 16; ++r) pmax = fmaxf(pmax, p0[r]);
#pragma unroll
  for (int r = 0; r < 16; ++r) pmax = fmaxf(pmax, p1[r]);
  { auto rr = __builtin_amdgcn_permlane32_swap(__float_as_uint(pmax), __float_as_uint(pmax), false, false);
    pmax = fmaxf(__uint_as_float(rr[0]), __uint_as_float(rr[1])); }
  pmax += c;
  float mn;
  if (__builtin_expect(__all(pmax - m_reg <= THR), 1)) { mn = m_reg; alpha = 1.f; }
  else { mn = fmaxf(m_reg, pmax); alpha = __builtin_amdgcn_exp2f(m_reg - mn); m_reg = mn; }
  const float sub = mn - c;
#pragma unroll
  for (int r = 0; r < 16; ++r) { p0[r] -= sub; p1[r] -= sub; }
#pragma unroll
  for (int r = 0; r < 16; ++r) p0[r] = __builtin_amdgcn_exp2f(p0[r]);
}
__device__ __forceinline__ void finishSM(f32x16& p0, f32x16& p1, float alpha, float& l_reg, bf16x8& pa0, bf16x8& pa1, bf16x8& pa2, bf16x8& pa3) {
#pragma unroll
  for (int r = 0; r < 16; ++r) p1[r] = __builtin_amdgcn_exp2f(p1[r]);
  float ps = 0;
#pragma unroll
  for (int r = 0; r < 16; ++r) ps += p0[r];
#pragma unroll
  for (int r = 0; r < 16; ++r) ps += p1[r];
  { auto rr = __builtin_amdgcn_permlane32_swap(__float_as_uint(ps), __float_as_uint(ps), false, false);
    ps = __uint_as_float(rr[0]) + __uint_as_float(rr[1]); }
  l_reg = l_reg * alpha + ps;
#define ATT_PK4(P, BASE, OUT) do { unsigned a0 = cvtpk(P[BASE + 0], P[BASE + 1]), a1 = cvtpk(P[BASE + 2], P[BASE + 3]);   \
    unsigned b0 = cvtpk(P[BASE + 4], P[BASE + 5]), b1 = cvtpk(P[BASE + 6], P[BASE + 7]);                              \
    auto r0 = __builtin_amdgcn_permlane32_swap(a0, b0, false, false); auto r1 = __builtin_amdgcn_permlane32_swap(a1, b1, false, false); \
    u32x4 w = {r0[0], r1[0], r0[1], r1[1]}; OUT = *reinterpret_cast<bf16x8*>(&w); } while (0)
  ATT_PK4(p0, 0, pa0); ATT_PK4(p0, 8, pa1); ATT_PK4(p1, 0, pa2); ATT_PK4(p1, 8, pa3);
#undef ATT_PK4
}
__device__ __forceinline__ void qkt(f32x16& p0, f32x16& p1, const char* Ks, const bf16x8* qr, int r32, int hi) {
  p0 = f32x16{}; p1 = f32x16{};
#pragma unroll
  for (int d0 = 0; d0 < 4; ++d0) { const int ch = d0 * 2 + hi;
    const bf16x8 b0 = *reinterpret_cast<const bf16x8*>(Ks + ATT_KS(r32, ch));
    const bf16x8 b1 = *reinterpret_cast<const bf16x8*>(Ks + ATT_KS(r32, ch) + 4096);
    p0 = __builtin_amdgcn_mfma_f32_32x32x16_bf16(b0, qr[d0], p0, 0, 0, 0);
    p1 = __builtin_amdgcn_mfma_f32_32x32x16_bf16(b1, qr[d0], p1, 0, 0, 0); }
}
__device__ __forceinline__ void add_bias(f32x16& p0, f32x16& p1, const int* kp, const float* lut, int qp, int hi) {
#pragma unroll
  for (int g = 0; g < 4; ++g) {
    const i32x4 ka = *reinterpret_cast<const i32x4*>(kp + 8 * g + 4 * hi), kb = *reinterpret_cast<const i32x4*>(kp + 32 + 8 * g + 4 * hi);
#pragma unroll
    for (int e = 0; e < 4; ++e) {
      int ia = ka[e] - qp; ia = ia < -128 ? -128 : ia; ia = ia > 128 ? 128 : ia;
      int ib = kb[e] - qp; ib = ib < -128 ? -128 : ib; ib = ib > 128 ? 128 : ib;
      p0[4 * g + e] += lut[ia + 128]; p1[4 * g + e] += lut[ib + 128]; }
    ATT_SBAR(); }
}
__device__ __forceinline__ int v_st(int k, int c) { const int kk = (k & ~0xC) | ((k & 4) << 1) | ((k & 8) >> 1); return ((kk >> 3) * 4 + (c >> 5)) * 512 + ((kk & 7) * 32 + (c & 31)) * 2; }
__device__ __forceinline__ int v_rd_base(int lane) { return ((lane & 3) << 3) | (((lane >> 2) & 3) << 6) | (((lane >> 4) & 1) << 5) | (((lane >> 5) & 1) << 8); }
constexpr int v_rd_off(int d0, int ks, int half) { return d0 * 512 + ks * 4096 + half * 2048; }
template <int OFF> __device__ __forceinline__ s16x4 tr_read(int vb) {
  s16x4 r; asm volatile("ds_read_b64_tr_b16 %0, %1 offset:%2" : "=&v"(r) : "v"(vb), "i"(OFF) : "memory"); return r;
}
template <int D0> __device__ __forceinline__ void pv_one(f32x16& od, int vb, bf16x8 pa0, bf16x8 pa1, bf16x8 pa2, bf16x8 pa3) {
  const s16x4 l0 = tr_read<v_rd_off(D0, 0, 0)>(vb), h0 = tr_read<v_rd_off(D0, 0, 1)>(vb), l1 = tr_read<v_rd_off(D0, 1, 0)>(vb), h1 = tr_read<v_rd_off(D0, 1, 1)>(vb);
  const s16x4 l2 = tr_read<v_rd_off(D0, 2, 0)>(vb), h2 = tr_read<v_rd_off(D0, 2, 1)>(vb), l3 = tr_read<v_rd_off(D0, 3, 0)>(vb), h3 = tr_read<v_rd_off(D0, 3, 1)>(vb);
  asm volatile("s_waitcnt lgkmcnt(0)" ::: "memory"); ATT_SBAR();
#define ATT_PK(L, H) (bf16x8){L[0], L[1], L[2], L[3], H[0], H[1], H[2], H[3]}
  od = __builtin_amdgcn_mfma_f32_32x32x16_bf16(pa0, ATT_PK(l0, h0), od, 0, 0, 0);
  od = __builtin_amdgcn_mfma_f32_32x32x16_bf16(pa1, ATT_PK(l1, h1), od, 0, 0, 0);
  od = __builtin_amdgcn_mfma_f32_32x32x16_bf16(pa2, ATT_PK(l2, h2), od, 0, 0, 0);
  od = __builtin_amdgcn_mfma_f32_32x32x16_bf16(pa3, ATT_PK(l3, h3), od, 0, 0, 0);
#undef ATT_PK
}
__device__ __forceinline__ void pv_d0(f32x16* o, int vb, bf16x8 pa0, bf16x8 pa1, bf16x8 pa2, bf16x8 pa3) {
  pv_one<0>(o[0], vb, pa0, pa1, pa2, pa3); pv_one<1>(o[1], vb, pa0, pa1, pa2, pa3); pv_one<2>(o[2], vb, pa0, pa1, pa2, pa3); pv_one<3>(o[3], vb, pa0, pa1, pa2, pa3);
}

struct Tensors { const bf16_t* Q; const bf16_t* K; const bf16_t* V; bf16_t* O; const int* pos; const float* rel_bias; const float* subln_g; float lam; };

__device__ __forceinline__ void attn_unit(const Tensors& T, int b, int h, int qb, char* lds) {
  int tid_ = threadIdx.x; asm volatile("" : "+v"(tid_));
  const int tid = tid_, wid = __builtin_amdgcn_readfirstlane(tid >> 6), lane = tid & 63, r32 = lane & 31, hi = lane >> 5;
  char* V_lds = lds + L_V; char* K_lds = lds + L_K;
  float* ws = (float*)(lds + L_WS) + wid * 64; float* li_l = ws; float* al_l = ws + 32;
  unsigned* stash = (unsigned*)(lds + L_ST) + wid * 2048;
  int* kpos = (int*)(lds + L_KP); float* lut = (float*)(lds + L_LUT); int* kmm = (int*)(lds + L_MM);
  const long rowbase = (long)b * SEQ;
  { const i32x4 pv4 = *reinterpret_cast<const i32x4*>(T.pos + rowbase + tid * 4); *reinterpret_cast<i32x4*>(kpos + tid * 4) = pv4; }
  if (tid < 257) { const int rel = tid - 128, n = rel < 0 ? -rel : rel;
    int bk = n < 8 ? n : (n < 12 ? 8 : (n < 16 ? 9 : (n < 23 ? 10 : (n < 32 ? 11 : (n < 46 ? 12 : (n < 64 ? 13 : (n < 91 ? 14 : 15)))))));
    if (rel > 0) bk += 16;
    lut[tid] = T.rel_bias[bk * NH + h] * LOG2E; }
  __syncthreads();
#pragma unroll
  for (int i = 0; i < 4; ++i) { const int t = wid * 4 + i; int v = kpos[t * 64 + lane], mn = v, mx = v;
#pragma unroll
    for (int o = 1; o < 64; o <<= 1) { mn = min(mn, __shfl_xor(mn, o)); mx = max(mx, __shfl_xor(mx, o)); }
    if (lane == 0) { kmm[t] = mn; kmm[32 + t] = mx; } }
  const int q0 = qb * (QBLK * NW) + wid * QBLK;
  const int qp = kpos[q0 + r32];
  int qmin = qp, qmax = qp;
#pragma unroll
  for (int o = 1; o < 32; o <<= 1) { qmin = min(qmin, __shfl_xor(qmin, o)); qmax = max(qmax, __shfl_xor(qmax, o)); }
  qmin = __builtin_amdgcn_readfirstlane(qmin); qmax = __builtin_amdgcn_readfirstlane(qmax);
  const float cL = T.rel_bias[15 * NH + h] * LOG2E, cR = T.rel_bias[31 * NH + h] * LOG2E;
  __syncthreads();
#define ATT_CLASS(t, NEAR, C) do { const int kmn_ = kmm[(t)], kmx_ = kmm[32 + (t)]; \
    if (kmn_ - qmax >= 128) { NEAR = false; C = cR; } else if (kmx_ - qmin <= -128) { NEAR = false; C = cL; } else { NEAR = true; C = 0.f; } } while (0)
#if defined(ATT_VARIANT) && (ATT_VARIANT & 1)
#define ATT_BIAS(P0, P1, t, C) do { C = 0.f; } while (0)
#else
#define ATT_BIAS(P0, P1, t, C) do { bool near_; ATT_CLASS(t, near_, C); if (near_) add_bias(P0, P1, kpos + (t) * KVBLK, lut, qp, hi); } while (0)
#endif

  const bf16_t* Vh = T.V + rowbase * LDP + h * VD;

#pragma nounroll
#if defined(ATT_VARIANT) && (ATT_VARIANT & 4)
  for (int map = 0; map < 1; ++map) {
#else
  for (int map = 0; map < 2; ++map) {
#endif
    int tm_ = tid; asm volatile("" : "+v"(tm_));
    const int tid = tm_, lane = tid & 63, r32 = lane & 31, hi = lane >> 5;
    const int sr = tid >> 4, sc = (tid & 15) * 8, vst0 = v_st(sr, sc), vst1 = v_st(32 + sr, sc);
    const int kr = tid >> 3, kch = tid & 7, kst = ATT_KS(kr, kch);
    const int vb0 = (int)(uintptr_t)V_lds + v_rd_base(lane);
    const unsigned voff = (unsigned)(sr * LDP + sc) * 2u, koff = (unsigned)(kr * LDP + kch * 8) * 2u;
    const bf16_t* Kh = T.K + rowbase * LDP + h * (2 * HD) + map * HD;
    const bf16_t* Qw = T.Q + (rowbase + q0 + r32) * LDP + h * (2 * HD) + map * HD + hi * 8;
    float m_reg = -1e30f, l_reg = 0; f32x16 o[4] = {}; bf16x8 qr[4];
#pragma unroll
    for (int d0 = 0; d0 < 4; ++d0) qr[d0] = *reinterpret_cast<const bf16x8*>(Qw + d0 * 16);
    struct { bf16x8 vs0, vs1, ks0; } sr_[SDEPTH];
#define SLOAD(i, k0) do { const char* Vt_ = (const char*)Vh + (size_t)(k0) * (LDP * 2); const char* Kt_ = (const char*)Kh + (size_t)(k0) * (LDP * 2); \
      sr_[i].vs0 = *reinterpret_cast<const bf16x8*>(Vt_ + voff); sr_[i].vs1 = *reinterpret_cast<const bf16x8*>(Vt_ + 32 * LDP * 2 + voff); \
      sr_[i].ks0 = *reinterpret_cast<const bf16x8*>(Kt_ + koff); } while (0)
#define SWRITE(bf, i) do { *(bf16x8*)(V_lds + (bf) * SHM_V + vst0) = sr_[i].vs0; *(bf16x8*)(V_lds + (bf) * SHM_V + vst1) = sr_[i].vs1; \
      *(bf16x8*)(K_lds + (bf) * SHM_K + kst) = sr_[i].ks0; } while (0)
#define SWAIT() do { if constexpr (SDEPTH == 2) asm volatile("s_waitcnt vmcnt(3)" ::: "memory"); else asm volatile("s_waitcnt vmcnt(0)" ::: "memory"); } while (0)
#define RESC(a) do { if (__any((a) < 1.f)) { if (hi == 0) al_l[r32] = (a); asm volatile("s_waitcnt lgkmcnt(0)" ::: "memory"); \
      _Pragma("unroll") for (int d = 0; d < 4; ++d) _Pragma("unroll") for (int r = 0; r < 16; ++r) o[d][r] *= al_l[crow(r, hi)]; } } while (0)
    f32x16 pA0, pA1, pB0, pB1; float alA, alB, cA, cB; bf16x8 pa0, pa1, pa2, pa3;
    constexpr int SE = 0, SO = SDEPTH - 1;
    SLOAD(SE, 0); asm volatile("s_waitcnt vmcnt(0)" ::: "memory"); SWRITE(0, SE); __syncthreads();
    qkt(pA0, pA1, K_lds, qr, r32, hi); ATT_BIAS(pA0, pA1, 0, cA); partialSM(pA0, pA1, cA, m_reg, alA);
    SLOAD(SO, KVBLK); if constexpr (SDEPTH == 2) SLOAD(SE, 2 * KVBLK);
    SWAIT(); SWRITE(1, SO); __syncthreads();
    for (int j = 1; j + 1 < NT; j += 2) {
      ATT_SBAR(); qkt(pB0, pB1, K_lds + SHM_K, qr, r32, hi);
      finishSM(pA0, pA1, alA, l_reg, pa0, pa1, pa2, pa3); ATT_SBAR();
      SLOAD(SO, (j + SDEPTH) * KVBLK); ATT_SBAR();
      pv_d0(o, vb0, pa0, pa1, pa2, pa3); ATT_BIAS(pB0, pB1, j, cB); partialSM(pB0, pB1, cB, m_reg, alB);
      __syncthreads(); SWAIT(); SWRITE(0, SE);
      RESC(alB); __syncthreads();
      ATT_SBAR(); qkt(pA0, pA1, K_lds, qr, r32, hi);
      finishSM(pB0, pB1, alB, l_reg, pa0, pa1, pa2, pa3); ATT_SBAR();
      if (SDEPTH == 1 || j + 3 < NT) SLOAD(SE, (j + 1 + SDEPTH) * KVBLK); ATT_SBAR();
      pv_d0(o, vb0 + SHM_V, pa0, pa1, pa2, pa3); ATT_BIAS(pA0, pA1, j + 1, cA); partialSM(pA0, pA1, cA, m_reg, alA);
      __syncthreads(); SWAIT(); SWRITE(1, SO);
      RESC(alA); __syncthreads();
    }
    ATT_SBAR(); qkt(pB0, pB1, K_lds + SHM_K, qr, r32, hi);
    finishSM(pA0, pA1, alA, l_reg, pa0, pa1, pa2, pa3); ATT_SBAR();
    pv_d0(o, vb0, pa0, pa1, pa2, pa3); ATT_BIAS(pB0, pB1, NT - 1, cB); partialSM(pB0, pB1, cB, m_reg, alB);
    __syncthreads(); RESC(alB);
    finishSM(pB0, pB1, alB, l_reg, pa0, pa1, pa2, pa3); ATT_SBAR();
    pv_d0(o, vb0 + SHM_V, pa0, pa1, pa2, pa3);
#undef SLOAD
#undef SWRITE
#undef SWAIT
#undef RESC
    int lane_e = lane; asm volatile("" : "+v"(lane_e));
    const int r32e = lane_e & 31, hie = lane_e >> 5;
    if (hie == 0) li_l[r32e] = l_reg; asm volatile("s_waitcnt lgkmcnt(0)" ::: "memory");
    float rli[16];
#pragma unroll
    for (int r = 0; r < 16; ++r) rli[r] = __builtin_amdgcn_rcpf(li_l[crow(r, hie)]);
    unsigned* stl = stash + lane_e;
#if defined(ATT_VARIANT) && (ATT_VARIANT & 2)
    if (true) {
#else
    if (map == 0) {
#endif
#pragma unroll
      for (int d0 = 0; d0 < 4; ++d0)
#pragma unroll
        for (int r = 0; r < 16; r += 2) stl[(d0 * 8 + (r >> 1)) * 64] = cvtpk(o[d0][r] * rli[r], o[d0][r + 1] * rli[r + 1]);
    } else {
      const float lam = T.lam;
      float ssq[16];
#pragma unroll
      for (int r = 0; r < 16; ++r) ssq[r] = 0.f;
#pragma unroll
      for (int d0 = 0; d0 < 4; ++d0)
#pragma unroll
        for (int r = 0; r < 16; r += 2) { const unsigned w = stl[(d0 * 8 + (r >> 1)) * 64];
          const float a0 = __uint_as_float(w << 16) - lam * (o[d0][r] * rli[r]), a1 = __uint_as_float(w & 0xffff0000u) - lam * (o[d0][r + 1] * rli[r + 1]);
          o[d0][r] = a0; o[d0][r + 1] = a1; ssq[r] += a0 * a0; ssq[r + 1] += a1 * a1; }
#pragma unroll
      for (int r = 0; r < 16; ++r) {
        float v = ssq[r];
        v += __int_as_float(__builtin_amdgcn_ds_swizzle(__float_as_int(v), (1 << 10) | 0x1f));
        v += __int_as_float(__builtin_amdgcn_ds_swizzle(__float_as_int(v), (2 << 10) | 0x1f));
        v += __int_as_float(__builtin_amdgcn_ds_swizzle(__float_as_int(v), (4 << 10) | 0x1f));
        v += __int_as_float(__builtin_amdgcn_ds_swizzle(__float_as_int(v), (8 << 10) | 0x1f));
        v += __int_as_float(__builtin_amdgcn_ds_swizzle(__float_as_int(v), (16 << 10) | 0x1f));
        ssq[r] = rsqrtf(v * (1.0f / VD) + SUBLN_EPS) * (1.0f - LAMBDA_INIT); }
      float gs[4];
#pragma unroll
      for (int d0 = 0; d0 < 4; ++d0) gs[d0] = T.subln_g[d0 * 32 + r32e];
      bf16_t* Owl = T.O + (rowbase + q0 + 4 * hie) * LDP + h * VD + r32e;
#pragma unroll
      for (int r = 0; r < 16; ++r) { const int orow = (r & 3) + 8 * (r >> 2);
#pragma unroll
        for (int d0 = 0; d0 < 4; ++d0) { const float v = o[d0][r] * ssq[r] * gs[d0]; unsigned u = __builtin_bit_cast(unsigned, v); u = (u + 0x7fffu + ((u >> 16) & 1u)) >> 16;
          Owl[(long)orow * LDP + d0 * 32] = (bf16_t)u; } }
    }
    __syncthreads();
  }
#undef ATT_CLASS
#undef ATT_BIAS
}
#undef ATT_KS
#undef ATT_SBAR
}
#define GAS __attribute__((address_space(1)))
#define LAS __attribute__((address_space(3)))
typedef unsigned short bf16;
typedef unsigned v4u __attribute__((ext_vector_type(4)));
typedef float f32x4 __attribute__((ext_vector_type(4)));
typedef short bf16x8 __attribute__((ext_vector_type(8)));
typedef GAS unsigned gu32;
typedef GAS unsigned long long gu64;
#define RLX_AGENT __ATOMIC_RELAXED, __HIP_MEMORY_SCOPE_AGENT
#define LDS_WAIT() asm volatile("s_waitcnt lgkmcnt(0)" ::: "memory")
#define VM_WAIT() asm volatile("s_waitcnt vmcnt(0)" ::: "memory")
__device__ __forceinline__ unsigned long long rt() { return __builtin_amdgcn_s_memrealtime(); }
__device__ __forceinline__ unsigned f2bf(float f) { unsigned u = __builtin_bit_cast(unsigned, f); return (u + 0x7fffu + ((u >> 16) & 1u)) >> 16; }
__device__ __forceinline__ unsigned pk2(float lo, float hi) { return f2bf(lo) | (f2bf(hi) << 16); }

#define XB_TMO      128
#define XB_XCNT(j)  (256  + 64 * (j))
#define XB_XSUB(j)  (1280 + 64 * (j))
#define XB_XGEN(j)  (2304 + 64 * (j))
#define XB_TOP      3328
#define XB_TOPGEN   3392
#define XCD_BAR_WORDS 3456
#define XB_SPIN_CAP (1u << 18)

__device__ __forceinline__ unsigned xb_ld(unsigned* p)              { return __hip_atomic_load(p, __ATOMIC_RELAXED, __HIP_MEMORY_SCOPE_AGENT); }
__device__ __forceinline__ unsigned xb_add(unsigned* p, unsigned v) { return __hip_atomic_fetch_add(p, v, __ATOMIC_RELAXED, __HIP_MEMORY_SCOPE_AGENT); }
__device__ __forceinline__ unsigned xb_xcc_id() { return (unsigned)__builtin_amdgcn_s_getreg((3 << 11) | 20) & 0xFu; }
#define XB_SPIN(cond, bar) do { unsigned _sp = 0; while (cond) { __builtin_amdgcn_s_sleep(1); \
    if ((++_sp & 255u) == 0u) { if (xb_ld(&(bar)[XB_TMO])) break; if (_sp > XB_SPIN_CAP) { atomicAdd(&(bar)[XB_TMO], 1u); break; } } } } while (0)

struct XcdBarrier {
    unsigned* bar; unsigned x;
    volatile LAS unsigned* st;
};

__device__ __forceinline__ XcdBarrier xcd_barrier_post(unsigned* bar, volatile LAS unsigned* st) {
    XcdBarrier b; b.bar = bar; b.x = xb_xcc_id(); b.st = st;
    if (threadIdx.x == 0) (void)xb_add(&bar[XB_XCNT(b.x)], 1u);
    return b;
}
__device__ __forceinline__ void xcd_barrier_complete(unsigned* bar, unsigned x, unsigned& nloc, unsigned& nx) {
    const unsigned G = gridDim.x * gridDim.y * gridDim.z;
    unsigned sum, cnt, mine, sp = 0u;
    for (;;) {
        sum = 0u; cnt = 0u; mine = 0u;
#pragma unroll
        for (unsigned j = 0; j < 16; ++j) { const unsigned c = xb_ld(&bar[XB_XCNT(j)]); sum += c; cnt += (c > 0u) ? 1u : 0u; mine = (j == x) ? c : mine; }
        if (sum == G) break;
        __builtin_amdgcn_s_sleep(1);
        if ((++sp & 255u) == 0u) { if (xb_ld(&bar[XB_TMO])) break; if (sp > XB_SPIN_CAP) { atomicAdd(&bar[XB_TMO], 1u); break; } }
    }
    nloc = mine > 0u ? mine : 1u; nx = cnt > 0u ? cnt : 1u;
}

__device__ __forceinline__ void xcd_barrier(const XcdBarrier& b) {
    asm volatile("s_waitcnt vmcnt(0)" ::: "memory");
    __syncthreads();
    if (threadIdx.x == 0) {
        unsigned* bar = b.bar;
        __builtin_amdgcn_s_waitcnt(0);
        unsigned nloc = b.st[0], nx = b.st[1];
        if (nloc == 0u) { xcd_barrier_complete(bar, b.x, nloc, nx); b.st[0] = nloc; b.st[1] = nx; }
        const unsigned old = xb_add(&bar[XB_XSUB(b.x)], 1u);
        const unsigned gen = old / nloc;
        if (old + 1u == (gen + 1u) * nloc) {
            __builtin_amdgcn_fence(__ATOMIC_RELEASE, "agent");
            asm volatile("s_waitcnt vmcnt(0)" ::: "memory");
            const unsigned og = xb_add(&bar[XB_TOP], 1u);
            const unsigned tg = og / nx;
            if (og + 1u == (tg + 1u) * nx) xb_add(&bar[XB_TOPGEN], 1u);
            else XB_SPIN(xb_ld(&bar[XB_TOPGEN]) == tg, bar);
            __builtin_amdgcn_fence(__ATOMIC_ACQUIRE, "agent");
            xb_add(&bar[XB_XGEN(b.x)], 1u);
            asm volatile("s_waitcnt vmcnt(0)" ::: "memory");
        } else {
            XB_SPIN(xb_ld(&bar[XB_XGEN(b.x)]) == gen, bar);
            __builtin_amdgcn_fence(__ATOMIC_ACQUIRE, "agent");
            asm volatile("s_waitcnt vmcnt(0)" ::: "memory");
        }
    }
    __syncthreads();
}

constexpr int NWAVES = 8;
constexpr size_t MiB = (size_t)1 << 20, HM = (size_t)1 << 19;
constexpr size_t WS_CTL = 0, CTL_ZERO_BYTES = 64 * 1024;
constexpr size_t WS_SSQ = 1 * MiB, SSQ_BYTES = (size_t)M * 4 * 4;
constexpr size_t WS_WGU1 = 4 * HM, WS_WD1 = 26 * HM, WS_WIN = 37 * HM, WS_WPQ = 53 * HM, WS_WAO = 57 * HM, WS_WOUT = 59 * HM, WS_WGU2 = 63 * HM, WS_WD2 = 85 * HM, WS_DFT = 96 * HM;
constexpr size_t WS_XB = 64 * MiB;
constexpr size_t WS_R = 96 * MiB;
constexpr size_t WS_H = WS_R, WS_UT = WS_R, WS_Q = WS_R + 16 * MiB, WS_K = WS_R + 32 * MiB, WS_V = WS_R + 48 * MiB, WS_GA = WS_R + 64 * MiB, WS_GB = WS_R + 96 * MiB, WS_O = WS_R + 128 * MiB;
constexpr size_t WS_TMP = WS_R;
constexpr size_t WS_END = WS_R + 144 * MiB;
static_assert(WS_K - WS_Q == 16 * MiB && WS_V - WS_K == 16 * MiB && WS_GB - WS_GA == 32 * MiB, "EpiWin pointer strides");
static_assert(WS_END <= 256 * MiB && WS_DFT + 32 * HM == WS_XB && WS_H + (size_t)M * FF * 2 <= WS_END, "d_ws map");
constexpr int CW_BAR = 4096;
constexpr int RING_BYTES = 131072, LDSCTL_OFF = RING_BYTES, MISC_OFF = LDSCTL_OFF + 320, PTR_OFF = LDSCTL_OFF + 1024, LDS_BYTES = 147456;
constexpr int CTL_LDS_WORDS = 256;

__device__ __forceinline__ float wave_sum(float v) {
#pragma unroll
    for (int o = 1; o < 64; o <<= 1) v += __shfl_xor(v, o);
    return v;
}
__device__ __forceinline__ void p0_transpose_item(const float* W, int K, int N, bf16* WT, const float* gain, int mode, LAS float* scr, int item, int lane) {
    const int nblk = N / 32, kb = item / nblk, nb = item % nblk, k0 = 64 * kb, n0 = 32 * nb;
#pragma unroll 8
    for (int i = 0; i < 32; ++i) { const int kk = 2 * i + (lane >> 5); float w = W[(size_t)(k0 + kk) * N + n0 + (lane & 31)]; if (gain) w *= gain[k0 + kk]; scr[kk * 33 + (lane & 31)] = w; }
    LDS_WAIT(); asm volatile("" ::: "memory");
    const int c = lane & 7;
#pragma unroll
    for (int j = 0; j < 4; ++j) { const int nl = (lane >> 3) + 8 * j, n = n0 + nl; const LAS float* s = scr + (8 * c) * 33 + nl;
        const int drow = mode == 0 ? n : (((n >> 7) << 8) + (n & 127) + (mode == 2 ? 128 : 0));
        v4u o; o.x = pk2(s[0 * 33], s[1 * 33]); o.y = pk2(s[2 * 33], s[3 * 33]); o.z = pk2(s[4 * 33], s[5 * 33]); o.w = pk2(s[6 * 33], s[7 * 33]);
        *(GAS v4u*)(WT + (size_t)drow * K + k0 + 8 * c) = o; }
    LDS_WAIT(); asm volatile("" ::: "memory");
}

#ifndef PHMASK
#define PHMASK 0xfff
#endif
#define PH(k) ((PHMASK >> (k)) & 1)
__device__ __forceinline__ const GAS float* in_ptr(LAS unsigned char* L, int i) {
    const unsigned long long v = ((const LAS unsigned long long*)(L + PTR_OFF))[i];
    const unsigned lo = __builtin_amdgcn_readfirstlane((unsigned)v), hi = __builtin_amdgcn_readfirstlane((unsigned)(v >> 32));
    return (const GAS float*)(uintptr_t)(((unsigned long long)hi << 32) | lo);
}
#define INF(i) ((const float*)in_ptr(L, (i)))
struct Args { const void* in[22]; float* out; unsigned char* ws; };

__global__ void __launch_bounds__(NWAVES * 64, 2) enc_fwd(Args args) {
    extern __shared__ __attribute__((aligned(16))) unsigned char lds[];
    LAS unsigned char* L = (LAS unsigned char*)lds;
    volatile LAS unsigned* MISC = (volatile LAS unsigned*)(L + MISC_OFF);
    const int tid = threadIdx.x, lane = tid & 63, wave = __builtin_amdgcn_readfirstlane(tid >> 6);
    const int G = gridDim.x, bx = blockIdx.x, vcu = (G % 8 == 0) ? (bx % 8) * (G / 8) + bx / 8 : bx;
    unsigned char* ws = args.ws;
    gu32* ctl = (gu32*)(ws + WS_CTL);
    float* out = args.out;
    bf16 *WGU1 = (bf16*)(ws + WS_WGU1), *WD1 = (bf16*)(ws + WS_WD1), *WIN = (bf16*)(ws + WS_WIN), *WPQ = (bf16*)(ws + WS_WPQ), *WAO = (bf16*)(ws + WS_WAO), *WOUT = (bf16*)(ws + WS_WOUT);
    bf16 *WGU2 = (bf16*)(ws + WS_WGU2), *WD2 = (bf16*)(ws + WS_WD2), *DFTM = (bf16*)(ws + WS_DFT);
    bf16 *XB = (bf16*)(ws + WS_XB), *PQ = XB, *HB = (bf16*)(ws + WS_H), *UT = (bf16*)(ws + WS_UT), *QB = (bf16*)(ws + WS_Q), *KB = (bf16*)(ws + WS_K), *VB = (bf16*)(ws + WS_V);
    bf16 *GA = (bf16*)(ws + WS_GA), *GB = (bf16*)(ws + WS_GB), *OB = (bf16*)(ws + WS_O);
    float* TMP = (float*)(ws + WS_TMP);
    float *SSQ0 = (float*)(ws + WS_SSQ), *SSQ1 = SSQ0 + (size_t)M * 4, *SSQ2 = SSQ1 + (size_t)M * 4, *SSQ3 = SSQ2 + (size_t)M * 4;

    for (int u = tid; u < CTL_LDS_WORDS; u += NWAVES * 64) ((LAS unsigned*)(L + LDSCTL_OFF))[u] = 0u;
    if (tid < 22) ((LAS unsigned long long*)(L + PTR_OFF))[tid] = (unsigned long long)(uintptr_t)args.in[tid];
    __syncthreads();
    XcdBarrier bar = xcd_barrier_post((unsigned*)(ctl + CW_BAR), MISC + 8);
    const int gw = vcu * NWAVES + wave, NGW = G * NWAVES;

    if constexpr (PH(0)) {
        LAS float* scr = (LAS float*)(L + wave * 16384);
        LAS float* trig = (LAS float*)(L + RING_BYTES - 1024);
        if (tid < 128) { float s, c; sincospif((float)tid * (1.0f / 64.0f), &s, &c); trig[tid] = c; trig[128 + tid] = s; }
        __syncthreads();
        constexpr int I_GU = (D / 64) * (FF / 32), I_DN = (FF / 64) * (D / 32), I_IN = (D / 64) * (INW / 32), I_AO = (FW / 64) * (D / 32), I_OUT = (D / 64) * (D / 32);
        constexpr int NITEMS = 4 * I_GU + 2 * I_DN + I_IN + I_AO + I_OUT;
        for (int it = gw; it < NITEMS; it += NGW) {
            int r = it;
            if (r < I_GU) { p0_transpose_item(INF(4), D, FF, WGU1, INF(3), 1, scr, r, lane); continue; } r -= I_GU;
            if (r < I_GU) { p0_transpose_item(INF(5), D, FF, WGU1, INF(3), 2, scr, r, lane); continue; } r -= I_GU;
            if (r < I_GU) { p0_transpose_item(INF(18), D, FF, WGU2, INF(17), 1, scr, r, lane); continue; } r -= I_GU;
            if (r < I_GU) { p0_transpose_item(INF(19), D, FF, WGU2, INF(17), 2, scr, r, lane); continue; } r -= I_GU;
            if (r < I_DN) { p0_transpose_item(INF(6), FF, D, WD1, nullptr, 0, scr, r, lane); continue; } r -= I_DN;
            if (r < I_DN) { p0_transpose_item(INF(20), FF, D, WD2, nullptr, 0, scr, r, lane); continue; } r -= I_DN;
            if (r < I_IN) { p0_transpose_item(INF(8), D, INW, WIN, INF(7), 0, scr, r, lane); continue; } r -= I_IN;
            if (r < I_AO) { p0_transpose_item(INF(15), FW, D, WAO, nullptr, 0, scr, r, lane); continue; } r -= I_AO;
            p0_transpose_item(INF(16), D, D, WOUT, nullptr, 0, scr, r, lane);
        }
        for (int gid = vcu * (NWAVES * 64) + tid; gid < 1024 * 128; gid += G * NWAVES * 64) {
            const int n = gid & 1023, k0 = (gid >> 10) * 8; const bool isq = k0 >= 512; const int kk = k0 & 511, g = kk >> 7, c0 = kk & 127;
            const LAS float* tb = trig + (isq ? 128 : 0);
            float a[8];
#pragma unroll
            for (int i = 0; i < 8; ++i) a[i] = 0.f;
            const float* wf = INF(14) + (size_t)(g * 128) * D + n;
#pragma unroll 4
            for (int m = 0; m < 128; ++m) { const float w = wf[(size_t)m * D];
#pragma unroll
                for (int i = 0; i < 8; ++i) a[i] += tb[((c0 + i) * m) & 127] * w; }
            const float sc = isq ? -(1.0f / 512.0f) : (1.0f / 512.0f);
            v4u o; o.x = pk2(a[0] * sc, a[1] * sc); o.y = pk2(a[2] * sc, a[3] * sc); o.z = pk2(a[4] * sc, a[5] * sc); o.w = pk2(a[6] * sc, a[7] * sc);
            *(GAS v4u*)(WPQ + (size_t)n * 1024 + k0) = o;
        }
        for (int it = vcu * (NWAVES * 64) + tid; it < 4096 * 256; it += G * NWAVES * 64) {
            const int jr = it >> 8, s0 = (it & 255) * 8, jj = jr & 2047; const bool iss = jr >= 2048;
            float v[8];
#pragma unroll
            for (int i = 0; i < 8; ++i) { const int t = (jj * (s0 + i)) & 2047; const float a = (float)t * (1.0f / 1024.0f); v[i] = iss ? sinpif(a) : cospif(a); }
            v4u o; o.x = pk2(v[0], v[1]); o.y = pk2(v[2], v[3]); o.z = pk2(v[4], v[5]); o.w = pk2(v[6], v[7]);
            *(GAS v4u*)(DFTM + (size_t)jr * 2048 + s0) = o;
        }
        const float* xin = INF(0);
        for (int m = gw; m < M; m += NGW) {
            const GAS f32x4* xr = (const GAS f32x4*)(xin + (size_t)m * D) + lane; GAS unsigned long long* o8 = (GAS unsigned long long*)(XB + (size_t)m * D) + lane;
            float s = 0.f;
#pragma unroll
            for (int j = 0; j < 4; ++j) { const f32x4 v = xr[64 * j]; s += (v.x * v.x + v.y * v.y) + (v.z * v.z + v.w * v.w);
                o8[64 * j] = (unsigned long long)pk2(v.x, v.y) | ((unsigned long long)pk2(v.z, v.w) << 32); }
            s = wave_sum(s);
            if (lane == 0) *(GAS f32x4*)(SSQ0 + (size_t)m * 4) = (f32x4){s, 0.f, 0.f, 0.f};
        }
    }
    xcd_barrier(bar);

    if constexpr (PH(1)) { pg8::Gemm g{XB, WGU1, M, 2 * FF, D}; pg8::StaticOrder S; S.init(M, 2 * FF, G, bx);
      pg8::EpiSwiglu E{HB, SSQ0, FF};
      pg8::gemm_phase<pg8::EpiSwiglu, pg8::StaticOrder, true, true>(L, g, S, E); }
    xcd_barrier(bar);
    if constexpr (PH(2)) { pg8::Gemm g{HB, WD1, M, D, FF}; pg8::StaticOrder S; S.init(M, D, G, bx);
      pg8::EpiResid E{INF(0), out, XB, SSQ1, 0.5f, D};
      pg8::gemm_phase<pg8::EpiResid, pg8::StaticOrder, false, true>(L, g, S, E); }
    xcd_barrier(bar);
    if constexpr (PH(3)) { pg8::Gemm g{XB, WIN, M, INW, D}; pg8::StaticOrder S; S.init(M, INW, G, bx);
      pg8::EpiWin E{SSQ1, UT, QB, GA, QSCALE};
      pg8::gemm_phase<pg8::EpiWin, pg8::StaticOrder, true, true>(L, g, S, E); }
    xcd_barrier(bar);
    if constexpr (PH(4)) { pg8::Gemm g{DFTM, UT, 4096, 4096, SEQ}; pg8::DftOrder S{vcu};
      pg8::EpiDft E{PQ};
      pg8::gemm_phase<pg8::EpiDft, pg8::DftOrder, false, true>(L, g, S, E); }
    if constexpr (PH(10)) {
        float d1 = INF(9)[lane] * INF(10)[lane], d2 = INF(11)[lane] * INF(12)[lane]; d1 = wave_sum(d1); d2 = wave_sum(d2);
        const float lam = __builtin_bit_cast(float, __builtin_amdgcn_readfirstlane(__builtin_bit_cast(int, expf(d1) - expf(d2) + LAMBDA_INIT)));
        att::Tensors T{QB, KB, VB, OB, (const int*)(const GAS int*)in_ptr(L, 1), INF(2), INF(13), lam};
        if (vcu < BATCH * NH * 8) { const int bh = vcu >> 3; att::attn_unit(T, bh >> 2, bh & 3, vcu & 7, (char*)lds); }
    }
    xcd_barrier(bar);
    if constexpr (PH(5)) { pg8::Gemm g{PQ, WPQ, M, D, D}; pg8::StaticOrder S; S.init(M, D, G, bx);
      pg8::EpiGateA E{GA, TMP};
      pg8::gemm_phase<pg8::EpiGateA, pg8::StaticOrder, false, true>(L, g, S, E); }
    if constexpr (PH(11)) { pg8::Gemm g{OB, WAO, M, D, FW}; pg8::StaticOrder S; S.init(M, D, G, bx);
      pg8::EpiGateB E{GB, TMP};
      pg8::gemm_phase<pg8::EpiGateB, pg8::StaticOrder, false, true>(L, g, S, E); }
    xcd_barrier(bar);
    if constexpr (PH(6)) { pg8::Gemm g{GB, WOUT, M, D, D}; pg8::StaticOrder S; S.init(M, D, G, bx);
      pg8::EpiResid E{out, out, XB, SSQ2, 1.0f, D};
      pg8::gemm_phase<pg8::EpiResid, pg8::StaticOrder, false, true>(L, g, S, E); }
    xcd_barrier(bar);
    if constexpr (PH(7)) { pg8::Gemm g{XB, WGU2, M, 2 * FF, D}; pg8::StaticOrder S; S.init(M, 2 * FF, G, bx);
      pg8::EpiSwiglu E{HB, SSQ2, FF};
      pg8::gemm_phase<pg8::EpiSwiglu, pg8::StaticOrder, true, true>(L, g, S, E); }
    xcd_barrier(bar);
    if constexpr (PH(8)) { pg8::Gemm g{HB, WD2, M, D, FF}; pg8::StaticOrder S; S.init(M, D, G, bx);
      pg8::EpiResid E{out, out, nullptr, SSQ3, 0.5f, D};
      pg8::gemm_phase<pg8::EpiResid, pg8::StaticOrder, false, true>(L, g, S, E); }
    xcd_barrier(bar);
    const float* nfgp = INF(21);
    if constexpr (PH(9)) for (int m = gw; m < M; m += NGW) {
        const f32x4 sq = *(const GAS f32x4*)(SSQ3 + (size_t)m * 4); const float rs = rsqrtf(((sq.x + sq.y) + (sq.z + sq.w)) * (1.0f / D) + NORM_EPS);
        GAS f32x4* xr = (GAS f32x4*)(out + (size_t)m * D) + lane; const GAS f32x4* gr = (const GAS f32x4*)nfgp + lane;
#pragma unroll
        for (int j = 0; j < 4; ++j) { const f32x4 v = xr[64 * j], gg = gr[64 * j]; xr[64 * j] = v * rs * gg; }
    }
}

extern "C" void kernel_launch(void* const* d_in, const int* in_sizes, int n_in, void* d_out, int out_size, void* d_ws, size_t ws_size, hipStream_t stream) {
    static int grid = 0;
    if (grid == 0) {
        if (n_in != 22 || in_sizes[0] != M * D || out_size != M * D || ws_size < WS_END) { fprintf(stderr, "kernel_launch: unexpected shapes (n_in %d, in0 %d, out %d, ws %zu); nothing launched\n", n_in, n_in > 0 ? in_sizes[0] : -1, out_size, ws_size); grid = -1; return; }
        int dev = 0, cus = 0, per_cu = 0;
        if (hipGetDevice(&dev) != hipSuccess || hipDeviceGetAttribute(&cus, hipDeviceAttributeMultiprocessorCount, dev) != hipSuccess) { fprintf(stderr, "kernel_launch: device query failed\n"); grid = -1; return; }
        if (hipFuncSetAttribute((const void*)enc_fwd, hipFuncAttributeMaxDynamicSharedMemorySize, LDS_BYTES) != hipSuccess) { fprintf(stderr, "kernel_launch: hipFuncSetAttribute failed\n"); grid = -1; return; }
        if (hipOccupancyMaxActiveBlocksPerMultiprocessor(&per_cu, (const void*)enc_fwd, NWAVES * 64, LDS_BYTES) != hipSuccess || per_cu < 1) { fprintf(stderr, "kernel_launch: occupancy query reports %d blocks per CU\n", per_cu); }
        (void)hipGetLastError();
        grid = 256;
        if (cus < 256) { fprintf(stderr, "kernel_launch: %d CUs < 256: the grid would not be resident; nothing launched\n", cus); grid = -1; return; }
    }
    if (grid < 0) return;
    if (hipMemsetAsync((char*)d_ws + WS_CTL, 0, CTL_ZERO_BYTES, stream) != hipSuccess) { fprintf(stderr, "kernel_launch: memset failed\n"); return; }
    Args a{};
    for (int i = 0; i < 22; ++i) a.in[i] = d_in[i];
    a.out = (float*)d_out; a.ws = (unsigned char*)d_ws;
    hipLaunchKernelGGL(enc_fwd, dim3(grid), dim3(NWAVES * 64), LDS_BYTES, stream, a);
    const hipError_t le = hipPeekAtLastError();
    if (le != hipSuccess) fprintf(stderr, "kernel_launch: launch failed: %s\n", hipGetErrorName(le));
}
```

```cpp
#include <hip/hip_runtime.h>
#include <hip/hip_bf16.h>
#include <cstdio>
#include <cstdint>
#include <cmath>

constexpr int BATCH = 8, SEQ = 2048, D = 1024, M = BATCH * SEQ, FF = 2816, INW = 4096;
constexpr int NH = 4, HD = 64, VD = 128, FW = 512;
constexpr float NORM_EPS = 1e-6f, SUBLN_EPS = 1e-5f, LAMBDA_INIT = 0.2f;
constexpr float LOG2E = 1.4426950408889634f;
constexpr float QSCALE = 0.125f * LOG2E;
namespace pg8 {
#define PG8_LAS __attribute__((address_space(3)))
typedef unsigned short bf16_t;
typedef short bf16x8 __attribute__((ext_vector_type(8)));
typedef float f32x4 __attribute__((ext_vector_type(4)));
typedef unsigned u32x4 __attribute__((ext_vector_type(4)));
constexpr int BM = 256, BK = 64, HALF = 128, HTB = HALF * BK * 2  , STAGE_BYTES = 8 * HTB, NXCD = 8, WGM = 8;

__host__ __device__ __forceinline__ int lds_byte(int r, int c) { const int st = (r >> 4) * 2 + (c >> 5), rr = r & 15, cc = c & 31, ob = rr * 64 + cc * 2; return st * 1024 + (ob ^ (((ob >> 9) & 1) << 5)); }
__host__ __device__ __forceinline__ void stage_rc(int b, int& R, int& C) { const int st = b / 1024, sb = b % 1024, swz = sb ^ (((sb >> 9) & 1) << 5); R = (st >> 1) * 16 + swz / 64; C = (st & 1) * 32 + (swz % 64) / 2; }
__host__ __device__ __forceinline__ int perm32(int rho) { const int n = rho >> 4, i = rho & 15; return 8 * (i >> 2) + 4 * n + (i & 3); }

struct Unit { int pm, pn; };
struct Gemm { const bf16_t* A; const bf16_t* Bt; int M, N, K; };

struct StaticOrder {
    int nM, nN, nwg, G, c;
    __host__ __device__ void init(int M, int N, int G_, int c_) { nM = M / BM; nN = N / BM; nwg = nM * nN; G = G_; c = c_; }
    __host__ __device__ bool next(int i, Unit& u) const {
        const long L = (long)i * G + c; if (L >= nwg) return false;
        int wgid = (int)L; { const int q = nwg / NXCD, r = nwg % NXCD, xcd = wgid % NXCD, off = wgid / NXCD; wgid = (xcd < r ? xcd * (q + 1) : r * (q + 1) + (xcd - r) * q) + off; }
        const int nig = WGM * nN, gid = wgid / nig, fm = gid * WGM, gsz = (nM - fm) < WGM ? (nM - fm) : WGM;
        u.pm = fm + ((wgid % nig) % gsz); u.pn = (wgid % nig) / gsz; return true;
    }
    __device__ __forceinline__ void a_ready(const Unit&) const {}
    __device__ __forceinline__ void done(const Unit&) const {}
};


__device__ __forceinline__ unsigned cvt_pk_bf16(float lo, float hi) { unsigned r; asm volatile("v_cvt_pk_bf16_f32 %0, %1, %2" : "=v"(r) : "v"(lo), "v"(hi)); return r; }
typedef unsigned u32x2 __attribute__((ext_vector_type(2)));
__device__ __forceinline__ float bf_lo(unsigned w) { return __uint_as_float(w << 16); }
__device__ __forceinline__ float bf_hi(unsigned w) { return __uint_as_float(w & 0xffff0000u); }
__device__ __forceinline__ unsigned short f2bf_s(float f) { unsigned u = __builtin_bit_cast(unsigned, f); return (unsigned short)((u + 0x7fffu + ((u >> 16) & 1u)) >> 16); }
__device__ __forceinline__ u32x4 pack8(const f32x4& a, const f32x4& b) { u32x4 w; w.x = cvt_pk_bf16(a[0], a[1]); w.y = cvt_pk_bf16(a[2], a[3]); w.z = cvt_pk_bf16(b[0], b[1]); w.w = cvt_pk_bf16(b[2], b[3]); return w; }
__device__ __forceinline__ float rstd_row(const float* ssq4, int row) { const f32x4 s = *(const f32x4*)(ssq4 + (size_t)row * 4); return rsqrtf(((s[0] + s[1]) + (s[2] + s[3])) * (1.0f / 1024.0f) + 1e-6f); }
__device__ __forceinline__ float silu1(float x) { return x * __builtin_amdgcn_rcpf(1.0f + __builtin_amdgcn_exp2f(-1.4426950408889634f * x)); }
__device__ __forceinline__ float sigm1(float x) { return __builtin_amdgcn_rcpf(1.0f + __builtin_amdgcn_exp2f(-1.4426950408889634f * x)); }

struct EpiSwiglu {
    static constexpr bool PERM = true, AFTER_DRAIN = false;
    bf16_t* H; const float* ssq4; int ldh;
    __device__ __forceinline__ void operator()(const f32x4 (&acc)[2][2][4][2], const Unit& u, int wr, int wc, int fr, int fq) const {
        const int row0 = u.pm * BM + wr * 64 + fr, col0 = u.pn * HALF + wc * 32 + 8 * fq;
#pragma unroll
        for (int ai = 0; ai < 2; ++ai)
#pragma unroll
            for (int m = 0; m < 4; ++m) { const int row = row0 + ai * HALF + m * 16; const float rs = rstd_row(ssq4, row);
                f32x4 h0, h1;
#pragma unroll
                for (int e = 0; e < 4; ++e) { h0[e] = silu1(acc[ai][0][m][0][e] * rs) * (acc[ai][1][m][0][e] * rs); h1[e] = silu1(acc[ai][0][m][1][e] * rs) * (acc[ai][1][m][1][e] * rs); }
                *(u32x4*)(H + (size_t)row * ldh + col0) = pack8(h0, h1); }
    }
};

struct EpiResid {
    static constexpr bool PERM = false, AFTER_DRAIN = true;
    const float* base; float* out; bf16_t* xb; float* ssq4; float alpha; int ldc;
    __device__ __forceinline__ void fused(f32x4 (&acc)[2][2][4][2], const Unit& u, int wr, int wc, int fr, int fq, PG8_LAS unsigned char* lds, int wid, int lane) const {
        PG8_LAS float* P = (PG8_LAS float*)lds;
        const int col0 = u.pn * BM + wc * 32 + 4 * fq;
#pragma unroll
        for (int ai = 0; ai < 2; ++ai)
#pragma unroll
            for (int m = 0; m < 4; ++m) { const int r = ai * HALF + wr * 64 + m * 16 + fr; const size_t off = (size_t)(u.pm * BM + r) * ldc + col0; float s = 0.f;
#pragma unroll
                for (int bj = 0; bj < 2; ++bj)
#pragma unroll
                    for (int n = 0; n < 2; ++n) { const f32x4 b = *(const f32x4*)(base + off + bj * HALF + n * 16); const f32x4 v = b + acc[ai][bj][m][n] * alpha;
                        *(f32x4*)(out + off + bj * HALF + n * 16) = v; s += (v[0] * v[0] + v[1] * v[1]) + (v[2] * v[2] + v[3] * v[3]);
                        if (xb) { u32x2 w; w.x = cvt_pk_bf16(v[0], v[1]); w.y = cvt_pk_bf16(v[2], v[3]); *(u32x2*)(xb + off + bj * HALF + n * 16) = w; } }
                s += __shfl_xor(s, 16); s += __shfl_xor(s, 32);
                if (fq == 0) P[r * 4 + wc] = s;
                if (m & 1) asm volatile("" ::: "memory"); }
        asm volatile("s_waitcnt lgkmcnt(0)" ::: "memory"); __builtin_amdgcn_s_barrier(); asm volatile("" ::: "memory");
        const int tid = wid * 64 + lane;
        if (tid < 256) { const PG8_LAS f32x4* p4 = (const PG8_LAS f32x4*)P; const f32x4 p = p4[tid]; ssq4[(size_t)(u.pm * BM + tid) * 4 + u.pn] = (p[0] + p[1]) + (p[2] + p[3]); }
    }
};

struct EpiWin {
    static constexpr bool PERM = true, AFTER_DRAIN = false;
    const float* ssq4; bf16_t *UT, *QKV, *GAB; float qscale;
    __device__ __forceinline__ void operator()(const f32x4 (&acc)[2][2][4][2], const Unit& u, int wr, int wc, int fr, int fq) const {
        const int row0 = u.pm * BM + wr * 64 + fr, cl = wc * 32 + 8 * fq, pn = u.pn;
        if (pn < 2) {
            const int b = u.pm >> 3, s0 = (u.pm & 7) * BM + wr * 64 + fr;
#pragma unroll
            for (int ai = 0; ai < 2; ++ai)
#pragma unroll
                for (int m = 0; m < 4; ++m) { const float rs = rstd_row(ssq4, row0 + ai * HALF + m * 16); const int s = s0 + ai * HALF + m * 16;
#pragma unroll
                    for (int bj = 0; bj < 2; ++bj)
#pragma unroll
                        for (int n = 0; n < 2; ++n)
#pragma unroll
                            for (int e = 0; e < 4; ++e) { const int c = pn * BM + bj * HALF + cl + 4 * n + e; UT[((size_t)(b * 512 + c)) * 2048 + s] = f2bf_s(acc[ai][bj][m][n][e] * rs); } }
        } else if (pn < 8) {
            bf16_t* dst = QKV + (size_t)((pn - 2) >> 1) * (8u << 20); const int cb = (pn & 1) * BM + cl; const float sc = pn < 4 ? qscale : 1.0f;
#pragma unroll
            for (int ai = 0; ai < 2; ++ai)
#pragma unroll
                for (int m = 0; m < 4; ++m) { const int row = row0 + ai * HALF + m * 16; const float rs = rstd_row(ssq4, row) * sc;
#pragma unroll
                    for (int bj = 0; bj < 2; ++bj) *(u32x4*)(dst + (size_t)row * 512 + cb + bj * HALF) = pack8(acc[ai][bj][m][0] * rs, acc[ai][bj][m][1] * rs); }
        } else {
            bf16_t* dst = GAB + (size_t)((pn - 8) >> 2) * (16u << 20); const int cb = ((pn - 8) & 3) * BM + cl;
#pragma unroll
            for (int ai = 0; ai < 2; ++ai)
#pragma unroll
                for (int m = 0; m < 4; ++m) { const int row = row0 + ai * HALF + m * 16; const float rs = rstd_row(ssq4, row);
#pragma unroll
                    for (int bj = 0; bj < 2; ++bj) { f32x4 a, b2;
#pragma unroll
                        for (int e = 0; e < 4; ++e) { a[e] = sigm1(acc[ai][bj][m][0][e] * rs); b2[e] = sigm1(acc[ai][bj][m][1][e] * rs); }
                        *(u32x4*)(dst + (size_t)row * 1024 + cb + bj * HALF) = pack8(a, b2); } }
        }
    }
};

struct EpiDft {
    static constexpr bool PERM = true, AFTER_DRAIN = false;
    bf16_t* PQ;
    __device__ __forceinline__ void operator()(const f32x4 (&acc)[2][2][4][2], const Unit& u, int wr, int wc, int fr, int fq) const {
        const int b = u.pn >> 1, row0 = b * 2048 + (u.pm & 7) * BM + wr * 64 + fr, col0 = (u.pm >> 3) * 512 + (u.pn & 1) * BM + wc * 32 + 8 * fq;
#pragma unroll
        for (int ai = 0; ai < 2; ++ai)
#pragma unroll
            for (int m = 0; m < 4; ++m) { const int row = row0 + ai * HALF + m * 16;
#pragma unroll
                for (int bj = 0; bj < 2; ++bj) *(u32x4*)(PQ + (size_t)row * 1024 + col0 + bj * HALF) = pack8(acc[ai][bj][m][0], acc[ai][bj][m][1]); }
    }
};

struct EpiGateA {
    static constexpr bool PERM = true, AFTER_DRAIN = false;
    const bf16_t* GA; float* TMP;
    __device__ __forceinline__ void operator()(const f32x4 (&acc)[2][2][4][2], const Unit& u, int wr, int wc, int fr, int fq) const {
        const int row0 = u.pm * BM + wr * 64 + fr, col0 = u.pn * BM + wc * 32 + 8 * fq;
#pragma unroll
        for (int ai = 0; ai < 2; ++ai)
#pragma unroll
            for (int m = 0; m < 4; ++m) { const int row = row0 + ai * HALF + m * 16;
#pragma unroll
                for (int bj = 0; bj < 2; ++bj) { const size_t off = (size_t)row * 1024 + col0 + bj * HALF; const u32x4 g = *(const u32x4*)(GA + off);
                    const f32x4 g0 = {bf_lo(g.x), bf_hi(g.x), bf_lo(g.y), bf_hi(g.y)}, g1 = {bf_lo(g.z), bf_hi(g.z), bf_lo(g.w), bf_hi(g.w)};
                    *(f32x4*)(TMP + off) = acc[ai][bj][m][0] * g0; *(f32x4*)(TMP + off + 4) = acc[ai][bj][m][1] * g1; } }
    }
};
struct EpiGateB {
    static constexpr bool PERM = true, AFTER_DRAIN = false;
    bf16_t* GB; const float* TMP;
    __device__ __forceinline__ void operator()(const f32x4 (&acc)[2][2][4][2], const Unit& u, int wr, int wc, int fr, int fq) const {
        const int row0 = u.pm * BM + wr * 64 + fr, col0 = u.pn * BM + wc * 32 + 8 * fq;
#pragma unroll
        for (int ai = 0; ai < 2; ++ai)
#pragma unroll
            for (int m = 0; m < 4; ++m) { const int row = row0 + ai * HALF + m * 16;
#pragma unroll
                for (int bj = 0; bj < 2; ++bj) { const size_t off = (size_t)row * 1024 + col0 + bj * HALF; const u32x4 g = *(const u32x4*)(GB + off);
                    const f32x4 t0 = *(const f32x4*)(TMP + off), t1 = *(const f32x4*)(TMP + off + 4);
                    const f32x4 g0 = {bf_lo(g.x), bf_hi(g.x), bf_lo(g.y), bf_hi(g.y)}, g1 = {bf_lo(g.z), bf_hi(g.z), bf_lo(g.w), bf_hi(g.w)};
                    *(u32x4*)(GB + off) = pack8(t0 + acc[ai][bj][m][0] * g0, t1 + acc[ai][bj][m][1] * g1); } }
    }
};
struct DftOrder {
    int c;
    __device__ __forceinline__ bool next(int i, Unit& u) const { if (i != 0 || c >= 256) return false; u.pm = c & 15; u.pn = c >> 4; return true; }
    __device__ __forceinline__ void a_ready(const Unit&) const {}
    __device__ __forceinline__ void done(const Unit&) const {}
};
struct TwiceOrder : StaticOrder {
    __device__ __forceinline__ bool next(int i, Unit& u) const { const int per = (nwg + G - 1) / G; if (i >= 2 * per) return false; return StaticOrder::next(i >= per ? i - per : i, u); }
};
template <class Epi, class Sched, bool ALIGN_EPI = false, bool SP2 = false>
__device__ __forceinline__ void gemm_phase(PG8_LAS unsigned char* lds, const Gemm g, const Sched& S, const Epi& E) {
    int tid_l = threadIdx.x; asm volatile("" : "+v"(tid_l));
    const int tid = tid_l, wid = __builtin_amdgcn_readfirstlane(tid >> 6), lane = tid & 63, wr = wid >> 2, wc = wid & 3, fr = lane & 15, fq = lane >> 4;
    const int K = g.K, nt = K / BK;
    unsigned voffA[2], voffB[2];
#pragma unroll
    for (int i = 0; i < 2; ++i) { int R, C; stage_rc(tid * 16 + i * 8192, R, C); const int Rb = Epi::PERM ? ((R & ~31) + perm32(R & 31)) : R;
        voffA[i] = (unsigned)(R * K + C) * 2u; voffB[i] = (unsigned)(Rb * K + C) * 2u; }
    const size_t kstep = (size_t)(BK * 2);
    const size_t hstep = (size_t)HALF * K * 2;
    const size_t tstep = 2 * hstep;
    const unsigned ldsw = (unsigned)wid * 1024u;
    const int aoff = lds_byte(wr * 64 + fr, fq * 8), boff = lds_byte(wc * 32 + fr, fq * 8);
#define PG8_SA(b, h) (((b) * 2 + (h)) * HTB)
#define PG8_SB(b, h) ((4 + (b) * 2 + (h)) * HTB)
#define PG8_STAGE(bufoff, gbase, voff) do { _Pragma("unroll") for (int _i = 0; _i < 2; ++_i) \
        __builtin_amdgcn_global_load_lds((const unsigned*)((const char*)(gbase) + (voff)[_i]), (PG8_LAS unsigned*)(lds + (bufoff) + ldsw + _i * 8192), 16, 0, 0); } while (0)
#define PG8_LDA(dst, b, h) do { _Pragma("unroll") for (int m = 0; m < 4; ++m) _Pragma("unroll") for (int k = 0; k < 2; ++k) dst[m][k] = *(const PG8_LAS bf16x8*)(lds + PG8_SA(b, h) + aoff + m * 2048 + k * 1024); } while (0)
#define PG8_LDB(dst, b, h) do { _Pragma("unroll") for (int n = 0; n < 2; ++n) _Pragma("unroll") for (int k = 0; k < 2; ++k) dst[n][k] = *(const PG8_LAS bf16x8*)(lds + PG8_SB(b, h) + boff + n * 2048 + k * 1024); } while (0)
#define PG8_MMA(ai, bj, At, Bt) do { __builtin_amdgcn_s_setprio(1); _Pragma("unroll") for (int m = 0; m < 4; ++m) _Pragma("unroll") for (int n = 0; n < 2; ++n) _Pragma("unroll") for (int k = 0; k < 2; ++k) \
        acc[ai][bj][m][n] = __builtin_amdgcn_mfma_f32_16x16x32_bf16(Bt[n][k], At[m][k], acc[ai][bj][m][n], 0, 0, 0); __builtin_amdgcn_s_setprio(0); } while (0)
#define PG8_WAIT_V(n) asm volatile("s_waitcnt vmcnt(" #n ")" ::: "memory")
#define PG8_WAIT_L(n) asm volatile("s_waitcnt lgkmcnt(" #n ")" ::: "memory")
#define PG8_BAR __builtin_amdgcn_s_barrier()
#define PG8_SCHED __builtin_amdgcn_sched_barrier(0)
    Unit cur, nxt; int ui = 0;
    if (!S.next(0, cur)) return;
    f32x4 acc[2][2][4][2];
#pragma unroll
    for (int a = 0; a < 2; ++a)
#pragma unroll
        for (int b = 0; b < 2; ++b)
#pragma unroll
            for (int m = 0; m < 4; ++m)
#pragma unroll
                for (int n = 0; n < 2; ++n) acc[a][b][m][n] = (f32x4){0.f, 0.f, 0.f, 0.f};
    bf16x8 At[4][2], B0[2][2], B1[2][2];
    const char* cA = (const char*)g.A + (size_t)cur.pm * tstep; const char* cB = (const char*)g.Bt + (size_t)cur.pn * tstep;
    S.a_ready(cur);
    if constexpr (SP2) {
        PG8_STAGE(PG8_SB(0, 0), cB, voffB); PG8_STAGE(PG8_SB(0, 1), cB + hstep, voffB); PG8_STAGE(PG8_SA(0, 0), cA, voffA); PG8_STAGE(PG8_SA(0, 1), cA + hstep, voffA);
        if (wr == 1) PG8_BAR;
        PG8_WAIT_V(2); PG8_BAR;
        PG8_STAGE(PG8_SB(1, 0), cB + kstep, voffB); PG8_STAGE(PG8_SA(1, 0), cA + kstep, voffA); PG8_STAGE(PG8_SB(1, 1), cB + hstep + kstep, voffB);
        PG8_WAIT_V(6); PG8_BAR;
    } else {
        PG8_STAGE(PG8_SB(0, 0), cB, voffB); PG8_STAGE(PG8_SA(0, 0), cA, voffA); PG8_STAGE(PG8_SB(0, 1), cB + hstep, voffB); PG8_STAGE(PG8_SA(0, 1), cA + hstep, voffA);
        if (wr == 1) PG8_BAR;
        PG8_WAIT_V(4); PG8_BAR;
        PG8_STAGE(PG8_SB(1, 0), cB + kstep, voffB); PG8_STAGE(PG8_SA(1, 0), cA + kstep, voffA); PG8_STAGE(PG8_SB(1, 1), cB + hstep + kstep, voffB);
        PG8_WAIT_V(6); PG8_BAR;
    }
    for (;;) {
        const bool has_next = S.next(ui + 1, nxt);
        const char* nA = has_next ? (const char*)g.A + (size_t)nxt.pm * tstep : cA; const char* nB = has_next ? (const char*)g.Bt + (size_t)nxt.pn * tstep : cB;
        for (int t = 0; t < nt; t += 2) {
            const bool last = (t == nt - 2);
            const char* a1 = cA + (size_t)(t + 1) * kstep;
            const char* a2 = last ? nA : cA + (size_t)(t + 2) * kstep; const char* b2 = last ? nB : cB + (size_t)(t + 2) * kstep;
            const char* a3 = a2 + kstep; const char* b3 = b2 + kstep;
            if (last && has_next) S.a_ready(nxt);
            if constexpr (SP2) {
            PG8_LDB(B0, 0, 0); PG8_LDB(B1, 0, 1); PG8_SCHED; PG8_LDA(At, 0, 0); PG8_STAGE(PG8_SA(1, 1), a1 + hstep, voffA);
            PG8_WAIT_V(8); PG8_WAIT_L(0); PG8_BAR; PG8_MMA(0, 0, At, B0); PG8_MMA(0, 1, At, B1); PG8_BAR; PG8_SCHED;
            PG8_LDA(At, 0, 1); PG8_STAGE(PG8_SB(0, 0), b2, voffB); PG8_STAGE(PG8_SB(0, 1), b2 + hstep, voffB); PG8_STAGE(PG8_SA(0, 0), a2, voffA);
            PG8_WAIT_V(8); PG8_WAIT_L(0); PG8_BAR; PG8_MMA(1, 0, At, B0); PG8_MMA(1, 1, At, B1); PG8_BAR; PG8_SCHED;
            PG8_LDB(B0, 1, 0); PG8_LDB(B1, 1, 1); PG8_SCHED; PG8_LDA(At, 1, 0); PG8_STAGE(PG8_SA(0, 1), a2 + hstep, voffA);
            PG8_WAIT_V(8); PG8_WAIT_L(0); PG8_BAR; PG8_MMA(0, 0, At, B0); PG8_MMA(0, 1, At, B1); PG8_BAR; PG8_SCHED;
            PG8_LDA(At, 1, 1); PG8_STAGE(PG8_SB(1, 0), b3, voffB); PG8_STAGE(PG8_SB(1, 1), b3 + hstep, voffB); PG8_STAGE(PG8_SA(1, 0), a3, voffA);
            PG8_WAIT_V(8); PG8_WAIT_L(0); PG8_BAR; PG8_MMA(1, 0, At, B0); PG8_MMA(1, 1, At, B1); PG8_BAR; PG8_SCHED;
            } else {
            PG8_LDB(B0, 0, 0); PG8_SCHED; PG8_LDA(At, 0, 0); PG8_STAGE(PG8_SA(1, 1), a1 + hstep, voffA);
            PG8_WAIT_L(8); PG8_BAR; PG8_WAIT_L(0); PG8_MMA(0, 0, At, B0); PG8_BAR; PG8_SCHED;
            PG8_LDB(B1, 0, 1); PG8_STAGE(PG8_SB(0, 0), b2, voffB);
            PG8_BAR; PG8_WAIT_L(0); PG8_MMA(0, 1, At, B1); PG8_BAR;
            PG8_LDA(At, 0, 1); PG8_STAGE(PG8_SA(0, 0), a2, voffA);
            PG8_BAR; PG8_WAIT_L(0); PG8_MMA(1, 0, At, B0); PG8_BAR; PG8_SCHED;
            PG8_STAGE(PG8_SB(0, 1), b2 + hstep, voffB);
            PG8_WAIT_V(6); PG8_BAR; PG8_MMA(1, 1, At, B1); PG8_BAR;
            PG8_LDB(B0, 1, 0); PG8_SCHED; PG8_LDA(At, 1, 0); PG8_STAGE(PG8_SA(0, 1), a2 + hstep, voffA);
            PG8_WAIT_L(8); PG8_BAR; PG8_WAIT_L(0); PG8_MMA(0, 0, At, B0); PG8_BAR; PG8_SCHED;
            PG8_LDB(B1, 1, 1); PG8_STAGE(PG8_SB(1, 0), b3, voffB);
            PG8_BAR; PG8_WAIT_L(0); PG8_MMA(0, 1, At, B1); PG8_BAR;
            PG8_LDA(At, 1, 1); PG8_STAGE(PG8_SA(1, 0), a3, voffA);
            PG8_BAR; PG8_WAIT_L(0); PG8_MMA(1, 0, At, B0); PG8_BAR; PG8_SCHED;
            PG8_STAGE(PG8_SB(1, 1), b3 + hstep, voffB);
            PG8_WAIT_V(6); PG8_BAR; PG8_MMA(1, 1, At, B1); PG8_BAR;
            }
        }
        if constexpr (ALIGN_EPI) { if (wr == 0) PG8_BAR; }
        if constexpr (!Epi::AFTER_DRAIN) { E(acc, cur, wr, wc, fr, fq); S.done(cur); }
        if (!has_next) break;
#pragma unroll
        for (int a = 0; a < 2; ++a)
#pragma unroll
            for (int b = 0; b < 2; ++b)
#pragma unroll
                for (int m = 0; m < 4; ++m)
#pragma unroll
                    for (int n = 0; n < 2; ++n) acc[a][b][m][n] = (f32x4){0.f, 0.f, 0.f, 0.f};
        cur = nxt; cA = nA; cB = nB; ++ui;
        if constexpr (ALIGN_EPI) { if (wr == 1) PG8_BAR; }
    }
    PG8_WAIT_V(0);
    if constexpr (!ALIGN_EPI) { if (wr == 0) PG8_BAR; }
    PG8_BAR;
    if constexpr (Epi::AFTER_DRAIN) { E.fused(acc, cur, wr, wc, fr, fq, lds, wid, lane); S.done(cur); }
#undef PG8_SA
#undef PG8_SB
#undef PG8_STAGE
#undef PG8_LDA
#undef PG8_LDB
#undef PG8_MMA
#undef PG8_WAIT_V
#undef PG8_WAIT_L
#undef PG8_BAR
#undef PG8_SCHED
}
}

namespace att {
using bf16x8 = __attribute__((ext_vector_type(8))) short;
using s16x4  = __attribute__((ext_vector_type(4))) short;
using f32x16 = __attribute__((ext_vector_type(16))) float;
using u32x4  = __attribute__((ext_vector_type(4))) unsigned;
using i32x4  = __attribute__((ext_vector_type(4))) int;
typedef unsigned short bf16_t;
constexpr int NW = 8, QBLK = 32, KVBLK = 64, NT = SEQ / KVBLK, LDP = 512;
#ifndef ATT_SDEPTH
#define ATT_SDEPTH 1
#endif
constexpr int SDEPTH = ATT_SDEPTH;
constexpr float THR = 8.f;
constexpr int SHM_V = KVBLK * VD * 2, SHM_K = KVBLK * HD * 2;
constexpr int L_V = 0, L_K = 2 * SHM_V, L_WS = L_K + 2 * SHM_K, L_ST = L_WS + NW * 256, L_KP = L_ST + NW * 8192, L_LUT = L_KP + SEQ * 4, L_MM = L_LUT + 1280, L_END = L_MM + 256;
static_assert(L_END <= 131072, "attention LDS map");
#define ATT_KS(row, ch) ((row) * 128 + ((((ch) ^ (((row) >> 1) & 7))) << 4))
#define ATT_SBAR() __builtin_amdgcn_sched_barrier(0)
__device__ __forceinline__ int crow(int r, int hi) { return (r & 3) + 8 * (r >> 2) + 4 * hi; }
__device__ __forceinline__ unsigned cvtpk(float lo, float hi) { unsigned r; asm volatile("v_cvt_pk_bf16_f32 %0, %1, %2" : "=v"(r) : "v"(lo), "v"(hi)); return r; }

__device__ __forceinline__ void partialSM(f32x16& p0, f32x16& p1, float c, float& m_reg, float& alpha) {
  float pmax = p0[0];
#pragma unroll
  for (int r = 1; r < 16; ++r) pmax = fmaxf(pmax, p0[r]);
#pragma unroll
  for (int r = 0; r < 16; ++r) pmax = fmaxf(pmax, p1[r]);
  { auto rr = __builtin_amdgcn_permlane32_swap(__float_as_uint(pmax), __float_as_uint(pmax), false, false);
    pmax = fmaxf(__uint_as_float(rr[0]), __uint_as_float(rr[1])); }
  pmax += c;
  float mn;
  if (__builtin_expect(__all(pmax - m_reg <= THR), 1)) { mn = m_reg; alpha = 1.f; }
  else { mn = fmaxf(m_reg, pmax); alpha = __builtin_amdgcn_exp2f(m_reg - mn); m_reg = mn; }
  const float sub = mn - c;
#pragma unroll
  for (int r = 0; r < 16; ++r) { p0[r] -= sub; p1[r] -= sub; }
#pragma unroll
  for (int r = 0; r < 16; ++r) p0[r] = __builtin_amdgcn_exp2f(p0[r]);
}
__device__ __forceinline__ void finishSM(f32x16& p0, f32x16& p1, float alpha, float& l_reg, bf16x8& pa0, bf16x8& pa1, bf16x8& pa2, bf16x8& pa3) {
#pragma unroll
  for (int r = 0; r < 16; ++r) p1[r] = __builtin_amdgcn_exp2f(p1[r]);
  float ps = 0;
#pragma unroll
  for (int r = 0; r < 16; ++r) ps += p0[r];
#pragma unroll
  for (int r = 0; r < 16; ++r) ps += p1[r];
  { auto rr = __builtin_amdgcn_permlane32_swap(__float_as_uint(ps), __float_as_uint(ps), false, false);
    ps = __uint_as_float(rr[0]) + __uint_as_float(rr[1]); }
  l_reg = l_reg * alpha + ps;
#define ATT_PK4(P, BASE, OUT) do { unsigned a0 = cvtpk(P[BASE + 0], P[BASE + 1]), a1 = cvtpk(P[BASE + 2], P[BASE + 3]);   \
    unsigned b0 = cvtpk(P[BASE + 4], P[BASE + 5]), b1 = cvtpk(P[BASE + 6], P[BASE + 7]);                              \
    auto r0 = __builtin_amdgcn_permlane32_swap(a0, b0, false, false); auto r1 = __builtin_amdgcn_permlane32_swap(a1, b1, false, false); \
    u32x4 w = {r0[0], r1[0], r0[1], r1[1]}; OUT = *reinterpret_cast<bf16x8*>(&w); } while (0)
  ATT_PK4(p0, 0, pa0); ATT_PK4(p0, 8, pa1); ATT_PK4(p1, 0, pa2); ATT_PK4(p1, 8, pa3);
#undef ATT_PK4
}
__device__ __forceinline__ void qkt(f32x16& p0, f32x16& p1, const char* Ks, const bf16x8* qr, int r32, int hi) {
  p0 = f32x16{}; p1 = f32x16{};
#pragma unroll
  for (int d0 = 0; d0 < 4; ++d0) { const int ch = d0 * 2 + hi;
    const bf16x8 b0 = *reinterpret_cast<const bf16x8*>(Ks + ATT_KS(r32, ch));
    const bf16x8 b1 = *reinterpret_cast<const bf16x8*>(Ks + ATT_KS(r32, ch) + 4096);
    p0 = __builtin_amdgcn_mfma_f32_32x32x16_bf16(b0, qr[d0], p0, 0, 0, 0);
    p1 = __builtin_amdgcn_mfma_f32_32x32x16_bf16(b1, qr[d0], p1, 0, 0, 0); }
}
__device__ __forceinline__ void add_bias(f32x16& p0, f32x16& p1, const int* kp, const float* lut, int qp, int hi) {
#pragma unroll
  for (int g = 0; g < 4; ++g) {
    const i32x4 ka = *reinterpret_cast<const i32x4*>(kp + 8 * g + 4 * hi), kb = *reinterpret_cast<const i32x4*>(kp + 32 + 8 * g + 4 * hi);
#pragma unroll
    for (int e = 0; e < 4; ++e) {
      int ia = ka[e] - qp; ia = ia < -128 ? -128 : ia; ia = ia > 128 ? 128 : ia;
      int ib = kb[e] - qp; ib = ib < -128 ? -128 : ib; ib = ib > 128 ? 128 : ib;
      p0[4 * g + e] += lut[ia + 128]; p1[4 * g + e] += lut[ib + 128]; }
    ATT_SBAR(); }
}
__device__ __forceinline__ int v_st(int k, int c) { const int kk = (k & ~0xC) | ((k & 4) << 1) | ((k & 8) >> 1); return ((kk >> 3) * 4 + (c >> 5)) * 512 + ((kk & 7) * 32 + (c & 31)) * 2; }
__device__ __forceinline__ int v_rd_base(int lane) { return ((lane & 3) << 3) | (((lane >> 2) & 3) << 6) | (((lane >> 4) & 1) << 5) | (((lane >> 5) & 1) << 8); }
constexpr int v_rd_off(int d0, int ks, int half) { return d0 * 512 + ks * 4096 + half * 2048; }
template <int OFF> __device__ __forceinline__ s16x4 tr_read(int vb) {
  s16x4 r; asm volatile("ds_read_b64_tr_b16 %0, %1 offset:%2" : "=&v"(r) : "v"(vb), "i"(OFF) : "memory"); return r;
}
template <int D0> __device__ __forceinline__ void pv_one(f32x16& od, int vb, bf16x8 pa0, bf16x8 pa1, bf16x8 pa2, bf16x8 pa3) {
  const s16x4 l0 = tr_read<v_rd_off(D0, 0, 0)>(vb), h0 = tr_read<v_rd_off(D0, 0, 1)>(vb), l1 = tr_read<v_rd_off(D0, 1, 0)>(vb), h1 = tr_read<v_rd_off(D0, 1, 1)>(vb);
  const s16x4 l2 = tr_read<v_rd_off(D0, 2, 0)>(vb), h2 = tr_read<v_rd_off(D0, 2, 1)>(vb), l3 = tr_read<v_rd_off(D0, 3, 0)>(vb), h3 = tr_read<v_rd_off(D0, 3, 1)>(vb);
  asm volatile("s_waitcnt lgkmcnt(0)" ::: "memory"); ATT_SBAR();
#define ATT_PK(L, H) (bf16x8){L[0], L[1], L[2], L[3], H[0], H[1], H[2], H[3]}
  od = __builtin_amdgcn_mfma_f32_32x32x16_bf16(pa0, ATT_PK(l0, h0), od, 0, 0, 0);
  od = __builtin_amdgcn_mfma_f32_32x32x16_bf16(pa1, ATT_PK(l1, h1), od, 0, 0, 0);
  od = __builtin_amdgcn_mfma_f32_32x32x16_bf16(pa2, ATT_PK(l2, h2), od, 0, 0, 0);
  od = __builtin_amdgcn_mfma_f32_32x32x16_bf16(pa3, ATT_PK(l3, h3), od, 0, 0, 0);
#undef ATT_PK
}
__device__ __forceinline__ void pv_d0(f32x16* o, int vb, bf16x8 pa0, bf16x8 pa1, bf16x8 pa2, bf16x8 pa3) {
  pv_one<0>(o[0], vb, pa0, pa1, pa2, pa3); pv_one<1>(o[1], vb, pa0, pa1, pa2, pa3); pv_one<2>(o[2], vb, pa0, pa1, pa2, pa3); pv_one<3>(o[3], vb, pa0, pa1, pa2, pa3);
}

struct Tensors { const bf16_t* Q; const bf16_t* K; const bf16_t* V; bf16_t* O; const int* pos; const float* rel_bias; const float* subln_g; float lam; };

__device__ __forceinline__ void attn_unit(const Tensors& T, int b, int h, int qb, char* lds) {
  int tid_ = threadIdx.x; asm volatile("" : "+v"(tid_));
  const int tid = tid_, wid = __builtin_amdgcn_readfirstlane(tid >> 6), lane = tid & 63, r32 = lane & 31, hi = lane >> 5;
  char* V_lds = lds + L_V; char* K_lds = lds + L_K;
  float* ws = (float*)(lds + L_WS) + wid * 64; float* li_l = ws; float* al_l = ws + 32;
  unsigned* stash = (unsigned*)(lds + L_ST) + wid * 2048;
  int* kpos = (int*)(lds + L_KP); float* lut = (float*)(lds + L_LUT); int* kmm = (int*)(lds + L_MM);
  const long rowbase = (long)b * SEQ;
  { const i32x4 pv4 = *reinterpret_cast<const i32x4*>(T.pos + rowbase + tid * 4); *reinterpret_cast<i32x4*>(kpos + tid * 4) = pv4; }
  if (tid < 257) { const int rel = tid - 128, n = rel < 0 ? -rel : rel;
    int bk = n < 8 ? n : (n < 12 ? 8 : (n < 16 ? 9 : (n < 23 ? 10 : (n < 32 ? 11 : (n < 46 ? 12 : (n < 64 ? 13 : (n < 91 ? 14 : 15)))))));
    if (rel > 0) bk += 16;
    lut[tid] = T.rel_bias[bk * NH + h] * LOG2E; }
  __syncthreads();
#pragma unroll
  for (int i = 0; i < 4; ++i) { const int t = wid * 4 + i; int v = kpos[t * 64 + lane], mn = v, mx = v;
#pragma unroll
    for (int o = 1; o < 64; o <<= 1) { mn = min(mn, __shfl_xor(mn, o)); mx = max(mx, __shfl_xor(mx, o)); }
    if (lane == 0) { kmm[t] = mn; kmm[32 + t] = mx; } }
  const int q0 = qb * (QBLK * NW) + wid * QBLK;
  const int qp = kpos[q0 + r32];
  int qmin = qp, qmax = qp;
#pragma unroll
  for (int o = 1; o < 32; o <<= 1) { qmin = min(qmin, __shfl_xor(qmin, o)); qmax = max(qmax, __shfl_xor(qmax, o)); }
  qmin = __builtin_amdgcn_readfirstlane(qmin); qmax = __builtin_amdgcn_readfirstlane(qmax);
  const float cL = T.rel_bias[15 * NH + h] * LOG2E, cR = T.rel_bias[31 * NH + h] * LOG2E;
  __syncthreads();
#define ATT_CLASS(t, NEAR, C) do { const int kmn_ = kmm[(t)], kmx_ = kmm[32 + (t)]; \
    if (kmn_ - qmax >= 128) { NEAR = false; C = cR; } else if (kmx_ - qmin <= -128) { NEAR = false; C = cL; } else { NEAR = true; C = 0.f; } } while (0)
#if defined(ATT_VARIANT) && (ATT_VARIANT & 1)
#define ATT_BIAS(P0, P1, t, C) do { C = 0.f; } while (0)
#else
#define ATT_BIAS(P0, P1, t, C) do { bool near_; ATT_CLASS(t, near_, C); if (near_) add_bias(P0, P1, kpos + (t) * KVBLK, lut, qp, hi); } while (0)
#endif

  const bf16_t* Vh = T.V + rowbase * LDP + h * VD;

#pragma nounroll
#if defined(ATT_VARIANT) && (ATT_VARIANT & 4)
  for (int map = 0; map < 1; ++map) {
#else
  for (int map = 0; map < 2; ++map) {
#endif
    int tm_ = tid; asm volatile("" : "+v"(tm_));
    const int tid = tm_, lane = tid & 63, r32 = lane & 31, hi = lane >> 5;
    const int sr = tid >> 4, sc = (tid & 15) * 8, vst0 = v_st(sr, sc), vst1 = v_st(32 + sr, sc);
    const int kr = tid >> 3, kch = tid & 7, kst = ATT_KS(kr, kch);
    const int vb0 = (int)(uintptr_t)V_lds + v_rd_base(lane);
    const unsigned voff = (unsigned)(sr * LDP + sc) * 2u, koff = (unsigned)(kr * LDP + kch * 8) * 2u;
    const bf16_t* Kh = T.K + rowbase * LDP + h * (2 * HD) + map * HD;
    const bf16_t* Qw = T.Q + (rowbase + q0 + r32) * LDP + h * (2 * HD) + map * HD + hi * 8;
    float m_reg = -1e30f, l_reg = 0; f32x16 o[4] = {}; bf16x8 qr[4];
#pragma unroll
    for (int d0 = 0; d0 < 4; ++d0) qr[d0] = *reinterpret_cast<const bf16x8*>(Qw + d0 * 16);
    struct { bf16x8 vs0, vs1, ks0; } sr_[SDEPTH];
#define SLOAD(i, k0) do { const char* Vt_ = (const char*)Vh + (size_t)(k0) * (LDP * 2); const char* Kt_ = (const char*)Kh + (size_t)(k0) * (LDP * 2); \
      sr_[i].vs0 = *reinterpret_cast<const bf16x8*>(Vt_ + voff); sr_[i].vs1 = *reinterpret_cast<const bf16x8*>(Vt_ + 32 * LDP * 2 + voff); \
      sr_[i].ks0 = *reinterpret_cast<const bf16x8*>(Kt_ + koff); } while (0)
#define SWRITE(bf, i) do { *(bf16x8*)(V_lds + (bf) * SHM_V + vst0) = sr_[i].vs0; *(bf16x8*)(V_lds + (bf) * SHM_V + vst1) = sr_[i].vs1; \
      *(bf16x8*)(K_lds + (bf) * SHM_K + kst) = sr_[i].ks0; } while (0)
#define SWAIT() do { if constexpr (SDEPTH == 2) asm volatile("s_waitcnt vmcnt(3)" ::: "memory"); else asm volatile("s_waitcnt vmcnt(0)" ::: "memory"); } while (0)
#define RESC(a) do { if (__any((a) < 1.f)) { if (hi == 0) al_l[r32] = (a); asm volatile("s_waitcnt lgkmcnt(0)" ::: "memory"); \
      _Pragma("unroll") for (int d = 0; d < 4; ++d) _Pragma("unroll") for (int r = 0; r < 16; ++r) o[d][r] *= al_l[crow(r, hi)]; } } while (0)
    f32x16 pA0, pA1, pB0, pB1; float alA, alB, cA, cB; bf16x8 pa0, pa1, pa2, pa3;
    constexpr int SE = 0, SO = SDEPTH - 1;
    SLOAD(SE, 0); asm volatile("s_waitcnt vmcnt(0)" ::: "memory"); SWRITE(0, SE); __syncthreads();
    qkt(pA0, pA1, K_lds, qr, r32, hi); ATT_BIAS(pA0, pA1, 0, cA); partialSM(pA0, pA1, cA, m_reg, alA);
    SLOAD(SO, KVBLK); if constexpr (SDEPTH == 2) SLOAD(SE, 2 * KVBLK);
    SWAIT(); SWRITE(1, SO); __syncthreads();
    for (int j = 1; j + 1 < NT; j += 2) {
      ATT_SBAR(); qkt(pB0, pB1, K_lds + SHM_K, qr, r32, hi);
      finishSM(pA0, pA1, alA, l_reg, pa0, pa1, pa2, pa3); ATT_SBAR();
      SLOAD(SO, (j + SDEPTH) * KVBLK); ATT_SBAR();
      pv_d0(o, vb0, pa0, pa1, pa2, pa3); ATT_BIAS(pB0, pB1, j, cB); partialSM(pB0, pB1, cB, m_reg, alB);
      __syncthreads(); SWAIT(); SWRITE(0, SE);
      RESC(alB); __syncthreads();
      ATT_SBAR(); qkt(pA0, pA1, K_lds, qr, r32, hi);
      finishSM(pB0, pB1, alB, l_reg, pa0, pa1, pa2, pa3); ATT_SBAR();
      if (SDEPTH == 1 || j + 3 < NT) SLOAD(SE, (j + 1 + SDEPTH) * KVBLK); ATT_SBAR();
      pv_d0(o, vb0 + SHM_V, pa0, pa1, pa2, pa3); ATT_BIAS(pA0, pA1, j + 1, cA); partialSM(pA0, pA1, cA, m_reg, alA);
      __syncthreads(); SWAIT(); SWRITE(1, SO);
      RESC(alA); __syncthreads();
    }
    ATT_SBAR(); qkt(pB0, pB1, K_lds + SHM_K, qr, r32, hi);
    finishSM(pA0, pA1, alA, l_reg, pa0, pa1, pa2, pa3); ATT_SBAR();
    pv_d0(o, vb0, pa0, pa1, pa2, pa3); ATT_BIAS(pB0, pB1, NT - 1, cB); partialSM(pB0, pB1, cB, m_reg, alB);
    __syncthreads(); RESC(alB);
    finishSM(pB0, pB1, alB, l_reg, pa0, pa1, pa2, pa3); ATT_SBAR();
    pv_d0(o, vb0 + SHM_V, pa0, pa1, pa2, pa3);
#undef SLOAD
#undef SWRITE
#undef SWAIT
#undef RESC
    int lane_e = lane; asm volatile("" : "+v"(lane_e));
    const int r32e = lane_e & 31, hie = lane_e >> 5;
    if (hie == 0) li_l[r32e] = l_reg; asm volatile("s_waitcnt lgkmcnt(0)" ::: "memory");
    float rli[16];
#pragma unroll
    for (int r = 0; r < 16; ++r) rli[r] = __builtin_amdgcn_rcpf(li_l[crow(r, hie)]);
    unsigned* stl = stash + lane_e;
#if defined(ATT_VARIANT) && (ATT_VARIANT & 2)
    if (true) {
#else
    if (map == 0) {
#endif
#pragma unroll
      for (int d0 = 0; d0 < 4; ++d0)
#pragma unroll
        for (int r = 0; r < 16; r += 2) stl[(d0 * 8 + (r >> 1)) * 64] = cvtpk(o[d0][r] * rli[r], o[d0][r + 1] * rli[r + 1]);
    } else {
      const float lam = T.lam;
      float ssq[16];
#pragma unroll
      for (int r = 0; r < 16; ++r) ssq[r] = 0.f;
#pragma unroll
      for (int d0 = 0; d0 < 4; ++d0)
#pragma unroll
        for (int r = 0; r < 16; r += 2) { const unsigned w = stl[(d0 * 8 + (r >> 1)) * 64];
          const float a0 = __uint_as_float(w << 16) - lam * (o[d0][r] * rli[r]), a1 = __uint_as_float(w & 0xffff0000u) - lam * (o[d0][r + 1] * rli[r + 1]);
          o[d0][r] = a0; o[d0][r + 1] = a1; ssq[r] += a0 * a0; ssq[r + 1] += a1 * a1; }
#pragma unroll
      for (int r = 0; r < 16; ++r) {
        float v = ssq[r];
        v += __int_as_float(__builtin_amdgcn_ds_swizzle(__float_as_int(v), (1 << 10) | 0x1f));
        v += __int_as_float(__builtin_amdgcn_ds_swizzle(__float_as_int(v), (2 << 10) | 0x1f));
        v += __int_as_float(__builtin_amdgcn_ds_swizzle(__float_as_int(v), (4 << 10) | 0x1f));
        v += __int_as_float(__builtin_amdgcn_ds_swizzle(__float_as_int(v), (8 << 10) | 0x1f));
        v += __int_as_float(__builtin_amdgcn_ds_swizzle(__float_as_int(v), (16 << 10) | 0x1f));
        ssq[r] = rsqrtf(v * (1.0f / VD) + SUBLN_EPS) * (1.0f - LAMBDA_INIT); }
      float gs[4];
#pragma unroll
      for (int d0 = 0; d0 < 4; ++d0) gs[d0] = T.subln_g[d0 * 32 + r32e];
      bf16_t* Owl = T.O + (rowbase + q0 + 4 * hie) * LDP + h * VD + r32e;
#pragma unroll
      for (int r = 0; r < 16; ++r) { const int orow = (r & 3) + 8 * (r >> 2);
#pragma unroll
        for (int d0 = 0; d0 < 4; ++d0) { const float v = o[d0][r] * ssq[r] * gs[d0]; unsigned u = __builtin_bit_cast(unsigned, v); u = (u + 0x7fffu + ((u >> 16) & 1u)) >> 16;
          Owl[(long)orow * LDP + d0 * 32] = (bf16_t)u; } }
    }
    __syncthreads();
  }
#undef ATT_CLASS
#undef ATT_BIAS
}
#undef ATT_KS
#undef ATT_SBAR
}
#define GAS __attribute__((address_space(1)))
#define LAS __attribute__((address_space(3)))
typedef unsigned short bf16;
typedef unsigned v4u __attribute__((ext_vector_type(4)));
typedef float f32x4 __attribute__((ext_vector_type(4)));
typedef short bf16x8 __attribute__((ext_vector_type(8)));
typedef GAS unsigned gu32;
typedef GAS unsigned long long gu64;
#define RLX_AGENT __ATOMIC_RELAXED, __HIP_MEMORY_SCOPE_AGENT
#define LDS_WAIT() asm volatile("s_waitcnt lgkmcnt(0)" ::: "memory")
#define VM_WAIT() asm volatile("s_waitcnt vmcnt(0)" ::: "memory")
__device__ __forceinline__ unsigned long long rt() { return __builtin_amdgcn_s_memrealtime(); }
__device__ __forceinline__ unsigned f2bf(float f) { unsigned u = __builtin_bit_cast(unsigned, f); return (u + 0x7fffu + ((u >> 16) & 1u)) >> 16; }
__device__ __forceinline__ unsigned pk2(float lo, float hi) { return f2bf(lo) | (f2bf(hi) << 16); }

#define XB_TMO      128
#define XB_XCNT(j)  (256  + 64 * (j))
#define XB_XSUB(j)  (1280 + 64 * (j))
#define XB_XGEN(j)  (2304 + 64 * (j))
#define XB_TOP      3328
#define XB_TOPGEN   3392
#define XCD_BAR_WORDS 3456
#define XB_SPIN_CAP (1u << 18)

__device__ __forceinline__ unsigned xb_ld(unsigned* p)              { return __hip_atomic_load(p, __ATOMIC_RELAXED, __HIP_MEMORY_SCOPE_AGENT); }
__device__ __forceinline__ unsigned xb_add(unsigned* p, unsigned v) { return __hip_atomic_fetch_add(p, v, __ATOMIC_RELAXED, __HIP_MEMORY_SCOPE_AGENT); }
__device__ __forceinline__ unsigned xb_xcc_id() { return (unsigned)__builtin_amdgcn_s_getreg((3 << 11) | 20) & 0xFu; }
#define XB_SPIN(cond, bar) do { unsigned _sp = 0; while (cond) { __builtin_amdgcn_s_sleep(1); \
    if ((++_sp & 255u) == 0u) { if (xb_ld(&(bar)[XB_TMO])) break; if (_sp > XB_SPIN_CAP) { atomicAdd(&(bar)[XB_TMO], 1u); break; } } } } while (0)

struct XcdBarrier {
    unsigned* bar; unsigned x;
    volatile LAS unsigned* st;
};

__device__ __forceinline__ XcdBarrier xcd_barrier_post(unsigned* bar, volatile LAS unsigned* st) {
    XcdBarrier b; b.bar = bar; b.x = xb_xcc_id(); b.st = st;
    if (threadIdx.x == 0) (void)xb_add(&bar[XB_XCNT(b.x)], 1u);
    return b;
}
__device__ __forceinline__ void xcd_barrier_complete(unsigned* bar, unsigned x, unsigned& nloc, unsigned& nx) {
    const unsigned G = gridDim.x * gridDim.y * gridDim.z;
    unsigned sum, cnt, mine, sp = 0u;
    for (;;) {
        sum = 0u; cnt = 0u; mine = 0u;
#pragma unroll
        for (unsigned j = 0; j < 16; ++j) { const unsigned c = xb_ld(&bar[XB_XCNT(j)]); sum += c; cnt += (c > 0u) ? 1u : 0u; mine = (j == x) ? c : mine; }
        if (sum == G) break;
        __builtin_amdgcn_s_sleep(1);
        if ((++sp & 255u) == 0u) { if (xb_ld(&bar[XB_TMO])) break; if (sp > XB_SPIN_CAP) { atomicAdd(&bar[XB_TMO], 1u); break; } }
    }
    nloc = mine > 0u ? mine : 1u; nx = cnt > 0u ? cnt : 1u;
}

__device__ __forceinline__ void xcd_barrier(const XcdBarrier& b) {
    asm volatile("s_waitcnt vmcnt(0)" ::: "memory");
    __syncthreads();
    if (threadIdx.x == 0) {
        unsigned* bar = b.bar;
        __builtin_amdgcn_s_waitcnt(0);
        unsigned nloc = b.st[0], nx = b.st[1];
        if (nloc == 0u) { xcd_barrier_complete(bar, b.x, nloc, nx); b.st[0] = nloc; b.st[1] = nx; }
        const unsigned old = xb_add(&bar[XB_XSUB(b.x)], 1u);
        const unsigned gen = old / nloc;
        if (old + 1u == (gen + 1u) * nloc) {
            __builtin_amdgcn_fence(__ATOMIC_RELEASE, "agent");
            asm volatile("s_waitcnt vmcnt(0)" ::: "memory");
            const unsigned og = xb_add(&bar[XB_TOP], 1u);
            const unsigned tg = og / nx;
            if (og + 1u == (tg + 1u) * nx) xb_add(&bar[XB_TOPGEN], 1u);
            else XB_SPIN(xb_ld(&bar[XB_TOPGEN]) == tg, bar);
            __builtin_amdgcn_fence(__ATOMIC_ACQUIRE, "agent");
            xb_add(&bar[XB_XGEN(b.x)], 1u);
            asm volatile("s_waitcnt vmcnt(0)" ::: "memory");
        } else {
            XB_SPIN(xb_ld(&bar[XB_XGEN(b.x)]) == gen, bar);
            __builtin_amdgcn_fence(__ATOMIC_ACQUIRE, "agent");
            asm volatile("s_waitcnt vmcnt(0)" ::: "memory");
        }
    }
    __syncthreads();
}

constexpr int NWAVES = 8;
constexpr size_t MiB = (size_t)1 << 20, HM = (size_t)1 << 19;
constexpr size_t WS_CTL = 0, CTL_ZERO_BYTES = 64 * 1024;
constexpr size_t WS_SSQ = 1 * MiB, SSQ_BYTES = (size_t)M * 4 * 4;
constexpr size_t WS_WGU1 = 4 * HM, WS_WD1 = 26 * HM, WS_WIN = 37 * HM, WS_WPQ = 53 * HM, WS_WAO = 57 * HM, WS_WOUT = 59 * HM, WS_WGU2 = 63 * HM, WS_WD2 = 85 * HM, WS_DFT = 96 * HM;
constexpr size_t WS_XB = 64 * MiB;
constexpr size_t WS_R = 96 * MiB;
constexpr size_t WS_H = WS_R, WS_UT = WS_R, WS_Q = WS_R + 16 * MiB, WS_K = WS_R + 32 * MiB, WS_V = WS_R + 48 * MiB, WS_GA = WS_R + 64 * MiB, WS_GB = WS_R + 96 * MiB, WS_O = WS_R + 128 * MiB;
constexpr size_t WS_TMP = WS_R;
constexpr size_t WS_END = WS_R + 144 * MiB;
static_assert(WS_K - WS_Q == 16 * MiB && WS_V - WS_K == 16 * MiB && WS_GB - WS_GA == 32 * MiB, "EpiWin pointer strides");
static_assert(WS_END <= 256 * MiB && WS_DFT + 32 * HM == WS_XB && WS_H + (size_t)M * FF * 2 <= WS_END, "d_ws map");
constexpr int CW_BAR = 4096;
constexpr int RING_BYTES = 131072, LDSCTL_OFF = RING_BYTES, MISC_OFF = LDSCTL_OFF + 320, PTR_OFF = LDSCTL_OFF + 1024, LDS_BYTES = 147456;
constexpr int CTL_LDS_WORDS = 256;

__device__ __forceinline__ float wave_sum(float v) {
#pragma unroll
    for (int o = 1; o < 64; o <<= 1) v += __shfl_xor(v, o);
    return v;
}
typedef float f32x2g __attribute__((ext_vector_type(2)));
__device__ __forceinline__ void p0_cvt_item(const float* W, int K, int N, bf16* WT, const float* gain, int mode, int item, int lane) {
    const int kb32 = K / 32, nc = item / kb32, k0 = (item - nc * kb32) * 32, n = nc * 128 + 2 * lane;
    const int drow = mode == 0 ? n : (((n >> 7) << 8) + (n & 127) + (mode == 2 ? 128 : 0));
    const GAS f32x2g* src = (const GAS f32x2g*)(W + (size_t)k0 * N + n);
    f32x2g w[32];
#pragma unroll
    for (int i = 0; i < 32; ++i) w[i] = src[(size_t)i * (N / 2)];
    if (gain) {
#pragma unroll
        for (int i = 0; i < 32; ++i) { const float g = gain[k0 + i]; w[i] = w[i] * g; }
    }
    GAS v4u* d0 = (GAS v4u*)(WT + (size_t)drow * K + k0); GAS v4u* d1 = (GAS v4u*)(WT + (size_t)(drow + 1) * K + k0);
#pragma unroll
    for (int kb = 0; kb < 4; ++kb) {
        v4u a, b;
        a.x = pk2(w[8 * kb + 0].x, w[8 * kb + 1].x); a.y = pk2(w[8 * kb + 2].x, w[8 * kb + 3].x); a.z = pk2(w[8 * kb + 4].x, w[8 * kb + 5].x); a.w = pk2(w[8 * kb + 6].x, w[8 * kb + 7].x);
        b.x = pk2(w[8 * kb + 0].y, w[8 * kb + 1].y); b.y = pk2(w[8 * kb + 2].y, w[8 * kb + 3].y); b.z = pk2(w[8 * kb + 4].y, w[8 * kb + 5].y); b.w = pk2(w[8 * kb + 6].y, w[8 * kb + 7].y);
        d0[kb] = a; d1[kb] = b; }
}

#ifndef PHMASK
#define PHMASK 0xfff
#endif
#define PH(k) ((PHMASK >> (k)) & 1)
#ifndef PROBE_DUP
#define PROBE_DUP -1
#endif
#define REP(k) for (int rep_ = 0; rep_ < ((PROBE_DUP) == (k) ? 2 : 1); ++rep_)
__device__ __forceinline__ const GAS float* in_ptr(LAS unsigned char* L, int i) {
    const unsigned long long v = ((const LAS unsigned long long*)(L + PTR_OFF))[i];
    const unsigned lo = __builtin_amdgcn_readfirstlane((unsigned)v), hi = __builtin_amdgcn_readfirstlane((unsigned)(v >> 32));
    return (const GAS float*)(uintptr_t)(((unsigned long long)hi << 32) | lo);
}
#define INF(i) ((const float*)in_ptr(L, (i)))
struct Args { const void* in[22]; float* out; unsigned char* ws; };

__global__ void __launch_bounds__(NWAVES * 64, 2) enc_fwd(Args args) {
    extern __shared__ __attribute__((aligned(16))) unsigned char lds[];
    LAS unsigned char* L = (LAS unsigned char*)lds;
    volatile LAS unsigned* MISC = (volatile LAS unsigned*)(L + MISC_OFF);
    const int tid = threadIdx.x, lane = tid & 63, wave = __builtin_amdgcn_readfirstlane(tid >> 6);
    const int G = gridDim.x, bx = blockIdx.x, vcu = (G % 8 == 0) ? (bx % 8) * (G / 8) + bx / 8 : bx;
    unsigned char* ws = args.ws;
    gu32* ctl = (gu32*)(ws + WS_CTL);
    float* out = args.out;
    bf16 *WGU1 = (bf16*)(ws + WS_WGU1), *WD1 = (bf16*)(ws + WS_WD1), *WIN = (bf16*)(ws + WS_WIN), *WPQ = (bf16*)(ws + WS_WPQ), *WAO = (bf16*)(ws + WS_WAO), *WOUT = (bf16*)(ws + WS_WOUT);
    bf16 *WGU2 = (bf16*)(ws + WS_WGU2), *WD2 = (bf16*)(ws + WS_WD2), *DFTM = (bf16*)(ws + WS_DFT);
    bf16 *XB = (bf16*)(ws + WS_XB), *PQ = XB, *HB = (bf16*)(ws + WS_H), *UT = (bf16*)(ws + WS_UT), *QB = (bf16*)(ws + WS_Q), *KB = (bf16*)(ws + WS_K), *VB = (bf16*)(ws + WS_V);
    bf16 *GA = (bf16*)(ws + WS_GA), *GB = (bf16*)(ws + WS_GB), *OB = (bf16*)(ws + WS_O);
    float* TMP = (float*)(ws + WS_TMP);
    float *SSQ0 = (float*)(ws + WS_SSQ), *SSQ1 = SSQ0 + (size_t)M * 4, *SSQ2 = SSQ1 + (size_t)M * 4, *SSQ3 = SSQ2 + (size_t)M * 4;

    for (int u = tid; u < CTL_LDS_WORDS; u += NWAVES * 64) ((LAS unsigned*)(L + LDSCTL_OFF))[u] = 0u;
    if (tid < 22) ((LAS unsigned long long*)(L + PTR_OFF))[tid] = (unsigned long long)(uintptr_t)args.in[tid];
    __syncthreads();
    XcdBarrier bar = xcd_barrier_post((unsigned*)(ctl + CW_BAR), MISC + 8);
    const int gw = vcu * NWAVES + wave, NGW = G * NWAVES;

    if constexpr (PH(0)) {
        LAS float* trig = (LAS float*)(L + 0);
        LAS unsigned short* ctab = (LAS unsigned short*)(L + 1024);
        if (tid < 128) { float s, c; sincospif((float)tid * (1.0f / 64.0f), &s, &c); trig[tid] = c; trig[128 + tid] = s; }
#pragma unroll
        for (int i = 0; i < 4; ++i) { const int t = tid + i * (NWAVES * 64); ctab[t] = (unsigned short)f2bf(cospif((float)t * (1.0f / 1024.0f))); }
        __syncthreads();
        constexpr int I_GU = (D / 32) * (FF / 128), I_DN = (FF / 32) * (D / 128), I_IN = (D / 32) * (INW / 128), I_AO = (FW / 32) * (D / 128), I_OUT = (D / 32) * (D / 128);
        constexpr int NITEMS = 4 * I_GU + 2 * I_DN + I_IN + I_AO + I_OUT;
        for (int it = gw; it < NITEMS; it += NGW) {
            int r = it;
            if (r < I_GU) { p0_cvt_item(INF(4), D, FF, WGU1, INF(3), 1, r, lane); continue; } r -= I_GU;
            if (r < I_GU) { p0_cvt_item(INF(5), D, FF, WGU1, INF(3), 2, r, lane); continue; } r -= I_GU;
            if (r < I_GU) { p0_cvt_item(INF(18), D, FF, WGU2, INF(17), 1, r, lane); continue; } r -= I_GU;
            if (r < I_GU) { p0_cvt_item(INF(19), D, FF, WGU2, INF(17), 2, r, lane); continue; } r -= I_GU;
            if (r < I_DN) { p0_cvt_item(INF(6), FF, D, WD1, nullptr, 0, r, lane); continue; } r -= I_DN;
            if (r < I_DN) { p0_cvt_item(INF(20), FF, D, WD2, nullptr, 0, r, lane); continue; } r -= I_DN;
            if (r < I_IN) { p0_cvt_item(INF(8), D, INW, WIN, INF(7), 0, r, lane); continue; } r -= I_IN;
            if (r < I_AO) { p0_cvt_item(INF(15), FW, D, WAO, nullptr, 0, r, lane); continue; } r -= I_AO;
            p0_cvt_item(INF(16), D, D, WOUT, nullptr, 0, r, lane);
        }
        for (int tile = gw; tile < 1024; tile += NGW) {
            const int g = tile >> 8, kt = (tile >> 5) & 7, nt = tile & 31, hi = lane >> 5, r32 = lane & 31;
            const bool iss = kt >= 4; const int c = (kt & 3) * 32 + r32;
            const LAS float* tb = trig + (iss ? 128 : 0);
            const float* wf = INF(14) + (size_t)(g * 128 + hi) * D + nt * 32 + r32;
            pg8::f32x4 dummy; (void)dummy;
            typedef float f32x16p __attribute__((ext_vector_type(16)));
            f32x16p acc = {};
#pragma unroll 8
            for (int s = 0; s < 64; ++s) { const int m = 2 * s + hi; acc = __builtin_amdgcn_mfma_f32_32x32x2f32(tb[(c * m) & 127], wf[(size_t)(2 * s) * D], acc, 0, 0, 0); }
            const float sc = iss ? -(1.0f / 512.0f) : (1.0f / 512.0f);
            bf16* dst = WPQ + (size_t)(nt * 32 + r32) * 1024 + (iss ? 512 : 0) + g * 128 + (kt & 3) * 32 + 4 * hi;
#pragma unroll
            for (int q = 0; q < 4; ++q) { unsigned long long w8 = (unsigned long long)pk2(acc[4 * q] * sc, acc[4 * q + 1] * sc) | ((unsigned long long)pk2(acc[4 * q + 2] * sc, acc[4 * q + 3] * sc) << 32);
                *(GAS unsigned long long*)(dst + 8 * q) = w8; }
        }
        for (int it = vcu * (NWAVES * 64) + tid; it < 4096 * 256; it += G * NWAVES * 64) {
            const int jr = it >> 8, s0 = (it & 255) * 8, jj = jr & 2047; int t = jj * s0 - (jr >= 2048 ? 512 : 0);
            unsigned v[8];
#pragma unroll
            for (int i = 0; i < 8; ++i) { v[i] = ctab[t & 2047]; t += jj; }
            v4u o; o.x = v[0] | (v[1] << 16); o.y = v[2] | (v[3] << 16); o.z = v[4] | (v[5] << 16); o.w = v[6] | (v[7] << 16);
            *(GAS v4u*)(DFTM + (size_t)jr * 2048 + s0) = o;
        }
        const float* xin = INF(0);
        for (int m = gw; m < M; m += NGW) {
            const GAS f32x4* xr = (const GAS f32x4*)(xin + (size_t)m * D) + lane; GAS unsigned long long* o8 = (GAS unsigned long long*)(XB + (size_t)m * D) + lane;
            float s = 0.f;
#pragma unroll
            for (int j = 0; j < 4; ++j) { const f32x4 v = xr[64 * j]; s += (v.x * v.x + v.y * v.y) + (v.z * v.z + v.w * v.w);
                o8[64 * j] = (unsigned long long)pk2(v.x, v.y) | ((unsigned long long)pk2(v.z, v.w) << 32); }
            s = wave_sum(s);
            if (lane == 0) *(GAS f32x4*)(SSQ0 + (size_t)m * 4) = (f32x4){s, 0.f, 0.f, 0.f};
        }
        __syncthreads();
    }
    xcd_barrier(bar);

#ifdef PROBE_XBAR
    for (int xb_ = 0; xb_ < PROBE_XBAR; ++xb_) xcd_barrier(bar);
#endif
#ifdef PROBE_XBAR_S
    xcd_barrier(bar);
#endif
    if constexpr (PH(1)) REP(1) { pg8::Gemm g{XB, WGU1, M, 2 * FF, D}; pg8::StaticOrder S; S.init(M, 2 * FF, G, bx);
      pg8::EpiSwiglu E{HB, SSQ0, FF};
      pg8::gemm_phase<pg8::EpiSwiglu, pg8::StaticOrder, true, true>(L, g, S, E); }
    xcd_barrier(bar);
#ifdef PROBE_UNITS2_P2
    if constexpr (PH(2)) { pg8::Gemm g{HB, WD1, M, D, FF}; pg8::TwiceOrder S; S.init(M, D, G, bx);
      pg8::EpiResid E{INF(0), out, XB, SSQ1, 0.5f, D};
      pg8::gemm_phase<pg8::EpiResid, pg8::TwiceOrder, false, true>(L, g, S, E); }
#else
    if constexpr (PH(2)) REP(2) { pg8::Gemm g{HB, WD1, M, D, FF}; pg8::StaticOrder S; S.init(M, D, G, bx);
      pg8::EpiResid E{INF(0), out, XB, SSQ1, 0.5f, D};
      pg8::gemm_phase<pg8::EpiResid, pg8::StaticOrder, false, true>(L, g, S, E); }
#endif
    xcd_barrier(bar);
#ifdef PROBE_UNITS2_P3
    if constexpr (PH(3)) { pg8::Gemm g{XB, WIN, M, INW, D}; pg8::TwiceOrder S; S.init(M, INW, G, bx);
      pg8::EpiWin E{SSQ1, UT, QB, GA, QSCALE};
      pg8::gemm_phase<pg8::EpiWin, pg8::TwiceOrder, true, true>(L, g, S, E); }
#else
    if constexpr (PH(3)) REP(3) { pg8::Gemm g{XB, WIN, M, INW, D}; pg8::StaticOrder S; S.init(M, INW, G, bx);
      pg8::EpiWin E{SSQ1, UT, QB, GA, QSCALE};
      pg8::gemm_phase<pg8::EpiWin, pg8::StaticOrder, true, true>(L, g, S, E);
#ifdef PROBE_BAR3
      if (rep_ == 0) xcd_barrier(bar);
#endif
    }
#endif
    xcd_barrier(bar);
    if constexpr (PH(4)) REP(4) { pg8::Gemm g{DFTM, UT, 4096, 4096, SEQ}; pg8::DftOrder S{vcu};
      pg8::EpiDft E{PQ};
      pg8::gemm_phase<pg8::EpiDft, pg8::DftOrder, false, true>(L, g, S, E); }
    if constexpr (PH(10)) REP(10) {
        float d1 = INF(9)[lane] * INF(10)[lane], d2 = INF(11)[lane] * INF(12)[lane]; d1 = wave_sum(d1); d2 = wave_sum(d2);
        const float lam = __builtin_bit_cast(float, __builtin_amdgcn_readfirstlane(__builtin_bit_cast(int, expf(d1) - expf(d2) + LAMBDA_INIT)));
        att::Tensors T{QB, KB, VB, OB, (const int*)(const GAS int*)in_ptr(L, 1), INF(2), INF(13), lam};
        if (vcu < BATCH * NH * 8) { const int bh = vcu >> 3; att::attn_unit(T, bh >> 2, bh & 3, vcu & 7, (char*)lds); }
    }
    xcd_barrier(bar);
    if constexpr (PH(5)) REP(5) { pg8::Gemm g{PQ, WPQ, M, D, D}; pg8::StaticOrder S; S.init(M, D, G, bx);
      pg8::EpiGateA E{GA, TMP};
      pg8::gemm_phase<pg8::EpiGateA, pg8::StaticOrder, false, true>(L, g, S, E); }
    if constexpr (PH(11)) REP(11) { pg8::Gemm g{OB, WAO, M, D, FW}; pg8::StaticOrder S; S.init(M, D, G, bx);
      pg8::EpiGateB E{GB, TMP};
      pg8::gemm_phase<pg8::EpiGateB, pg8::StaticOrder, false, true>(L, g, S, E); }
    xcd_barrier(bar);
    if constexpr (PH(6)) REP(6) { pg8::Gemm g{GB, WOUT, M, D, D}; pg8::StaticOrder S; S.init(M, D, G, bx);
      pg8::EpiResid E{out, out, XB, SSQ2, 1.0f, D};
      pg8::gemm_phase<pg8::EpiResid, pg8::StaticOrder, false, true>(L, g, S, E); }
    xcd_barrier(bar);
    if constexpr (PH(7)) REP(7) { pg8::Gemm g{XB, WGU2, M, 2 * FF, D}; pg8::StaticOrder S; S.init(M, 2 * FF, G, bx);
      pg8::EpiSwiglu E{HB, SSQ2, FF};
      pg8::gemm_phase<pg8::EpiSwiglu, pg8::StaticOrder, true, true>(L, g, S, E); }
    xcd_barrier(bar);
    if constexpr (PH(8)) REP(8) { pg8::Gemm g{HB, WD2, M, D, FF}; pg8::StaticOrder S; S.init(M, D, G, bx);
      pg8::EpiResid E{out, out, nullptr, SSQ3, 0.5f, D};
      pg8::gemm_phase<pg8::EpiResid, pg8::StaticOrder, false, true>(L, g, S, E); }
    xcd_barrier(bar);
#ifdef PROBE_EBAR
    for (int xb_ = 0; xb_ < PROBE_EBAR; ++xb_) xcd_barrier(bar);
#endif
    const float* nfgp = INF(21);
    if constexpr (PH(9)) for (int m = gw; m < M; m += NGW) {
        const f32x4 sq = *(const GAS f32x4*)(SSQ3 + (size_t)m * 4); const float rs = rsqrtf(((sq.x + sq.y) + (sq.z + sq.w)) * (1.0f / D) + NORM_EPS);
        GAS f32x4* xr = (GAS f32x4*)(out + (size_t)m * D) + lane; const GAS f32x4* gr = (const GAS f32x4*)nfgp + lane;
#pragma unroll
        for (int j = 0; j < 4; ++j) { const f32x4 v = xr[64 * j], gg = gr[64 * j]; xr[64 * j] = v * rs * gg; }
    }
}

extern "C" void kernel_launch(void* const* d_in, const int* in_sizes, int n_in, void* d_out, int out_size, void* d_ws, size_t ws_size, hipStream_t stream) {
    static int grid = 0;
    if (grid == 0) {
        if (n_in != 22 || in_sizes[0] != M * D || out_size != M * D || ws_size < WS_END) { fprintf(stderr, "kernel_launch: unexpected shapes (n_in %d, in0 %d, out %d, ws %zu); nothing launched\n", n_in, n_in > 0 ? in_sizes[0] : -1, out_size, ws_size); grid = -1; return; }
        int dev = 0, cus = 0, per_cu = 0;
        if (hipGetDevice(&dev) != hipSuccess || hipDeviceGetAttribute(&cus, hipDeviceAttributeMultiprocessorCount, dev) != hipSuccess) { fprintf(stderr, "kernel_launch: device query failed\n"); grid = -1; return; }
        if (hipFuncSetAttribute((const void*)enc_fwd, hipFuncAttributeMaxDynamicSharedMemorySize, LDS_BYTES) != hipSuccess) { fprintf(stderr, "kernel_launch: hipFuncSetAttribute failed\n"); grid = -1; return; }
        if (hipOccupancyMaxActiveBlocksPerMultiprocessor(&per_cu, (const void*)enc_fwd, NWAVES * 64, LDS_BYTES) != hipSuccess || per_cu < 1) { fprintf(stderr, "kernel_launch: occupancy query reports %d blocks per CU\n", per_cu); }
        (void)hipGetLastError();
        grid = 256;
        if (cus < 256) { fprintf(stderr, "kernel_launch: %d CUs < 256: the grid would not be resident; nothing launched\n", cus); grid = -1; return; }
    }
    if (grid < 0) return;
    if (hipMemsetAsync((char*)d_ws + WS_CTL, 0, CTL_ZERO_BYTES, stream) != hipSuccess) { fprintf(stderr, "kernel_launch: memset failed\n"); return; }
    Args a{};
    for (int i = 0; i < 22; ++i) a.in[i] = d_in[i];
    a.out = (float*)d_out; a.ws = (unsigned char*)d_ws;
    hipLaunchKernelGGL(enc_fwd, dim3(grid), dim3(NWAVES * 64), LDS_BYTES, stream, a);
    const hipError_t le = hipPeekAtLastError();
    if (le != hipSuccess) fprintf(stderr, "kernel_launch: launch failed: %s\n", hipGetErrorName(le));
}
```

```cpp
#include <hip/hip_runtime.h>
#include <hip/hip_bf16.h>
#include <cstdio>
#include <cstdint>
#include <cmath>

constexpr int BATCH = 8, SEQ = 2048, D = 1024, M = BATCH * SEQ, FF = 2816, INW = 4096;
constexpr int NH = 4, HD = 64, VD = 128, FW = 512;
constexpr float NORM_EPS = 1e-6f, SUBLN_EPS = 1e-5f, LAMBDA_INIT = 0.2f;
constexpr float LOG2E = 1.4426950408889634f;
constexpr float QSCALE = 0.125f * LOG2E;
namespace pg8 {
#define PG8_LAS __attribute__((address_space(3)))
typedef unsigned short bf16_t;
typedef short bf16x8 __attribute__((ext_vector_type(8)));
typedef float f32x4 __attribute__((ext_vector_type(4)));
typedef unsigned u32x4 __attribute__((ext_vector_type(4)));
constexpr int BM = 256, BK = 64, HALF = 128, HTB = HALF * BK * 2  , STAGE_BYTES = 8 * HTB, NXCD = 8, WGM = 8;

__host__ __device__ __forceinline__ int lds_byte(int r, int c) { const int st = (r >> 4) * 2 + (c >> 5), rr = r & 15, cc = c & 31, ob = rr * 64 + cc * 2; return st * 1024 + (ob ^ (((ob >> 9) & 1) << 5)); }
__host__ __device__ __forceinline__ void stage_rc(int b, int& R, int& C) { const int st = b / 1024, sb = b % 1024, swz = sb ^ (((sb >> 9) & 1) << 5); R = (st >> 1) * 16 + swz / 64; C = (st & 1) * 32 + (swz % 64) / 2; }
__host__ __device__ __forceinline__ int perm32(int rho) { const int n = rho >> 4, i = rho & 15; return 8 * (i >> 2) + 4 * n + (i & 3); }

struct Unit { int pm, pn; };
struct Gemm { const bf16_t* A; const bf16_t* Bt; int M, N, K; };

struct StaticOrder {
    int nM, nN, nwg, G, c;
    __host__ __device__ void init(int M, int N, int G_, int c_) { nM = M / BM; nN = N / BM; nwg = nM * nN; G = G_; c = c_; }
    __host__ __device__ bool next(int i, Unit& u) const {
        const long L = (long)i * G + c; if (L >= nwg) return false;
        int wgid = (int)L; { const int q = nwg / NXCD, r = nwg % NXCD, xcd = wgid % NXCD, off = wgid / NXCD; wgid = (xcd < r ? xcd * (q + 1) : r * (q + 1) + (xcd - r) * q) + off; }
        const int nig = WGM * nN, gid = wgid / nig, fm = gid * WGM, gsz = (nM - fm) < WGM ? (nM - fm) : WGM;
        u.pm = fm + ((wgid % nig) % gsz); u.pn = (wgid % nig) / gsz; return true;
    }
    __device__ __forceinline__ void a_ready(const Unit&) const {}
    __device__ __forceinline__ void done(const Unit&) const {}
};


__device__ __forceinline__ unsigned cvt_pk_bf16(float lo, float hi) { unsigned r; asm volatile("v_cvt_pk_bf16_f32 %0, %1, %2" : "=v"(r) : "v"(lo), "v"(hi)); return r; }
typedef unsigned u32x2 __attribute__((ext_vector_type(2)));
__device__ __forceinline__ float bf_lo(unsigned w) { return __uint_as_float(w << 16); }
__device__ __forceinline__ float bf_hi(unsigned w) { return __uint_as_float(w & 0xffff0000u); }
__device__ __forceinline__ unsigned short f2bf_s(float f) { unsigned u = __builtin_bit_cast(unsigned, f); return (unsigned short)((u + 0x7fffu + ((u >> 16) & 1u)) >> 16); }
__device__ __forceinline__ u32x4 pack8(const f32x4& a, const f32x4& b) { u32x4 w; w.x = cvt_pk_bf16(a[0], a[1]); w.y = cvt_pk_bf16(a[2], a[3]); w.z = cvt_pk_bf16(b[0], b[1]); w.w = cvt_pk_bf16(b[2], b[3]); return w; }
__device__ __forceinline__ float rstd_row(const float* ssq4, int row) { const f32x4 s = *(const f32x4*)(ssq4 + (size_t)row * 4); return rsqrtf(((s[0] + s[1]) + (s[2] + s[3])) * (1.0f / 1024.0f) + 1e-6f); }
__device__ __forceinline__ float silu1(float x) { return x * __builtin_amdgcn_rcpf(1.0f + __builtin_amdgcn_exp2f(-1.4426950408889634f * x)); }
__device__ __forceinline__ float sigm1(float x) { return __builtin_amdgcn_rcpf(1.0f + __builtin_amdgcn_exp2f(-1.4426950408889634f * x)); }

struct EpiSwiglu {
    static constexpr bool PERM = true, AFTER_DRAIN = false; static constexpr int MID_K = -1;
    bf16_t* H; const float* ssq4; int ldh;
    __device__ __forceinline__ void operator()(const f32x4 (&acc)[2][2][4][2], const Unit& u, int wr, int wc, int fr, int fq) const {
        const int row0 = u.pm * BM + wr * 64 + fr, col0 = u.pn * HALF + wc * 32 + 8 * fq;
#pragma unroll
        for (int ai = 0; ai < 2; ++ai)
#pragma unroll
            for (int m = 0; m < 4; ++m) { const int row = row0 + ai * HALF + m * 16; const float rs = rstd_row(ssq4, row);
                f32x4 h0, h1;
#pragma unroll
                for (int e = 0; e < 4; ++e) { h0[e] = silu1(acc[ai][0][m][0][e] * rs) * (acc[ai][1][m][0][e] * rs); h1[e] = silu1(acc[ai][0][m][1][e] * rs) * (acc[ai][1][m][1][e] * rs); }
                *(u32x4*)(H + (size_t)row * ldh + col0) = pack8(h0, h1); }
    }
};

template <bool BASE16, bool OUT32, bool OUT16> struct EpiResid {
    static constexpr bool PERM = false, AFTER_DRAIN = true; static constexpr int MID_K = -1;
    const void* base; float* out; bf16_t* xb; float* ssq4; float alpha; int ldc;
    __device__ __forceinline__ void fused(f32x4 (&acc)[2][2][4][2], const Unit& u, int wr, int wc, int fr, int fq, PG8_LAS unsigned char* lds, int wid, int lane) const {
        PG8_LAS float* P = (PG8_LAS float*)lds;
        const int col0 = u.pn * BM + wc * 32 + 4 * fq;
#pragma unroll
        for (int ai = 0; ai < 2; ++ai)
#pragma unroll
            for (int m = 0; m < 4; ++m) { const int r = ai * HALF + wr * 64 + m * 16 + fr; const size_t off = (size_t)(u.pm * BM + r) * ldc + col0; float s = 0.f;
#pragma unroll
                for (int bj = 0; bj < 2; ++bj)
#pragma unroll
                    for (int n = 0; n < 2; ++n) { f32x4 b;
                        if constexpr (BASE16) { const u32x2 w = *(const u32x2*)((const bf16_t*)base + off + bj * HALF + n * 16); b = (f32x4){bf_lo(w.x), bf_hi(w.x), bf_lo(w.y), bf_hi(w.y)}; }
                        else b = *(const f32x4*)((const float*)base + off + bj * HALF + n * 16);
                        const f32x4 v = b + acc[ai][bj][m][n] * alpha;
                        s += (v[0] * v[0] + v[1] * v[1]) + (v[2] * v[2] + v[3] * v[3]);
                        if constexpr (OUT32) *(f32x4*)(out + off + bj * HALF + n * 16) = v;
                        if constexpr (OUT16) { u32x2 w; w.x = cvt_pk_bf16(v[0], v[1]); w.y = cvt_pk_bf16(v[2], v[3]); *(u32x2*)(xb + off + bj * HALF + n * 16) = w; } }
                s += __shfl_xor(s, 16); s += __shfl_xor(s, 32);
                if (fq == 0) P[r * 4 + wc] = s;
                if (m & 1) asm volatile("" ::: "memory"); }
        asm volatile("s_waitcnt lgkmcnt(0)" ::: "memory"); __builtin_amdgcn_s_barrier(); asm volatile("" ::: "memory");
        const int tid = wid * 64 + lane;
        if (tid < 256) { const PG8_LAS f32x4* p4 = (const PG8_LAS f32x4*)P; const f32x4 p = p4[tid]; ssq4[(size_t)(u.pm * BM + tid) * 4 + u.pn] = (p[0] + p[1]) + (p[2] + p[3]); }
    }
};

struct EpiWin {
    static constexpr bool PERM = true, AFTER_DRAIN = false; static constexpr int MID_K = -1;
    const float* ssq4; bf16_t *UT, *QKV, *GAB; float qscale;
    __device__ __forceinline__ void operator()(const f32x4 (&acc)[2][2][4][2], const Unit& u, int wr, int wc, int fr, int fq) const {
        const int row0 = u.pm * BM + wr * 64 + fr, cl = wc * 32 + 8 * fq, pn = u.pn;
        if (pn < 2) {
            const int b = u.pm >> 3, s0 = (u.pm & 7) * BM + wr * 64 + fr;
#pragma unroll
            for (int ai = 0; ai < 2; ++ai)
#pragma unroll
                for (int m = 0; m < 4; ++m) { const float rs = rstd_row(ssq4, row0 + ai * HALF + m * 16); const int s = s0 + ai * HALF + m * 16;
#pragma unroll
                    for (int bj = 0; bj < 2; ++bj)
#pragma unroll
                        for (int n = 0; n < 2; ++n)
#pragma unroll
                            for (int e = 0; e < 4; ++e) { const int c = pn * BM + bj * HALF + cl + 4 * n + e; UT[((size_t)(b * 512 + c)) * 2048 + s] = f2bf_s(acc[ai][bj][m][n][e] * rs); } }
        } else if (pn < 8) {
            bf16_t* dst = QKV + (size_t)((pn - 2) >> 1) * (8u << 20); const int cb = (pn & 1) * BM + cl; const float sc = pn < 4 ? qscale : 1.0f;
#pragma unroll
            for (int ai = 0; ai < 2; ++ai)
#pragma unroll
                for (int m = 0; m < 4; ++m) { const int row = row0 + ai * HALF + m * 16; const float rs = rstd_row(ssq4, row) * sc;
#pragma unroll
                    for (int bj = 0; bj < 2; ++bj) *(u32x4*)(dst + (size_t)row * 512 + cb + bj * HALF) = pack8(acc[ai][bj][m][0] * rs, acc[ai][bj][m][1] * rs); }
        } else {
            bf16_t* dst = GAB + (size_t)((pn - 8) >> 2) * (16u << 20); const int cb = ((pn - 8) & 3) * BM + cl;
#pragma unroll
            for (int ai = 0; ai < 2; ++ai)
#pragma unroll
                for (int m = 0; m < 4; ++m) { const int row = row0 + ai * HALF + m * 16; const float rs = rstd_row(ssq4, row);
#pragma unroll
                    for (int bj = 0; bj < 2; ++bj) { f32x4 a, b2;
#pragma unroll
                        for (int e = 0; e < 4; ++e) { a[e] = sigm1(acc[ai][bj][m][0][e] * rs); b2[e] = sigm1(acc[ai][bj][m][1][e] * rs); }
                        *(u32x4*)(dst + (size_t)row * 1024 + cb + bj * HALF) = pack8(a, b2); } }
        }
    }
};

struct EpiDft {
    static constexpr bool PERM = true, AFTER_DRAIN = false; static constexpr int MID_K = -1;
    bf16_t* PQ; int ldp;
    __device__ __forceinline__ void operator()(const f32x4 (&acc)[2][2][4][2], const Unit& u, int wr, int wc, int fr, int fq) const {
        const int b = u.pn >> 1, row0 = b * 2048 + (u.pm & 7) * BM + wr * 64 + fr, col0 = (u.pm >> 3) * 512 + (u.pn & 1) * BM + wc * 32 + 8 * fq;
#pragma unroll
        for (int ai = 0; ai < 2; ++ai)
#pragma unroll
            for (int m = 0; m < 4; ++m) { const int row = row0 + ai * HALF + m * 16;
#pragma unroll
                for (int bj = 0; bj < 2; ++bj) *(u32x4*)(PQ + (size_t)row * ldp + col0 + bj * HALF) = pack8(acc[ai][bj][m][0], acc[ai][bj][m][1]); }
    }
};

struct EpiGate {
    static constexpr bool PERM = true, AFTER_DRAIN = false; static constexpr int MID_K = 16;
    const bf16_t* GA; bf16_t* GB;
    __device__ __forceinline__ void mid(f32x4 (&acc)[2][2][4][2], const Unit& u, int wr, int wc, int fr, int fq) const {
        asm volatile("" : "+v"(fr), "+v"(fq));
        const int row0 = u.pm * BM + wr * 64 + fr, col0 = u.pn * BM + wc * 32 + 8 * fq;
#pragma unroll
        for (int ai = 0; ai < 2; ++ai)
#pragma unroll
            for (int m = 0; m < 4; ++m) { const int row = row0 + ai * HALF + m * 16;
#pragma unroll
                for (int bj = 0; bj < 2; ++bj) { const size_t off = (size_t)row * 1024 + col0 + bj * HALF; const u32x4 a = *(const u32x4*)(GA + off), b = *(const u32x4*)(GB + off);
                    const f32x4 r0 = {bf_lo(a.x) * __builtin_amdgcn_rcpf(bf_lo(b.x)), bf_hi(a.x) * __builtin_amdgcn_rcpf(bf_hi(b.x)), bf_lo(a.y) * __builtin_amdgcn_rcpf(bf_lo(b.y)), bf_hi(a.y) * __builtin_amdgcn_rcpf(bf_hi(b.y))};
                    const f32x4 r1 = {bf_lo(a.z) * __builtin_amdgcn_rcpf(bf_lo(b.z)), bf_hi(a.z) * __builtin_amdgcn_rcpf(bf_hi(b.z)), bf_lo(a.w) * __builtin_amdgcn_rcpf(bf_lo(b.w)), bf_hi(a.w) * __builtin_amdgcn_rcpf(bf_hi(b.w))};
                    acc[ai][bj][m][0] *= r0; acc[ai][bj][m][1] *= r1; }
                asm volatile("" ::: "memory"); }
    }
    __device__ __forceinline__ void operator()(const f32x4 (&acc)[2][2][4][2], const Unit& u, int wr, int wc, int fr, int fq) const {
        const int row0 = u.pm * BM + wr * 64 + fr, col0 = u.pn * BM + wc * 32 + 8 * fq;
#pragma unroll
        for (int ai = 0; ai < 2; ++ai)
#pragma unroll
            for (int m = 0; m < 4; ++m) { const int row = row0 + ai * HALF + m * 16;
#pragma unroll
                for (int bj = 0; bj < 2; ++bj) { const size_t off = (size_t)row * 1024 + col0 + bj * HALF; const u32x4 g = *(const u32x4*)(GB + off);
                    const f32x4 g0 = {bf_lo(g.x), bf_hi(g.x), bf_lo(g.y), bf_hi(g.y)}, g1 = {bf_lo(g.z), bf_hi(g.z), bf_lo(g.w), bf_hi(g.w)};
                    *(u32x4*)(GB + off) = pack8(acc[ai][bj][m][0] * g0, acc[ai][bj][m][1] * g1); } }
    }
};
struct DftOrder {
    int c;
    __device__ __forceinline__ bool next(int i, Unit& u) const { if (i != 0 || c >= 256) return false; u.pm = c & 15; u.pn = c >> 4; return true; }
    __device__ __forceinline__ void a_ready(const Unit&) const {}
    __device__ __forceinline__ void done(const Unit&) const {}
};
struct TwiceOrder : StaticOrder {
    __device__ __forceinline__ bool next(int i, Unit& u) const { const int per = (nwg + G - 1) / G; if (i >= 2 * per) return false; return StaticOrder::next(i >= per ? i - per : i, u); }
};
template <class Epi, class Sched, bool ALIGN_EPI = false, bool SP2 = false>
__device__ __forceinline__ void gemm_phase(PG8_LAS unsigned char* lds, const Gemm g, const Sched& S, const Epi& E) {
    int tid_l = threadIdx.x; asm volatile("" : "+v"(tid_l));
    const int tid = tid_l, wid = __builtin_amdgcn_readfirstlane(tid >> 6), lane = tid & 63, wr = wid >> 2, wc = wid & 3, fr = lane & 15, fq = lane >> 4;
    const int K = g.K, nt = K / BK;
    unsigned voffA[2], voffB[2];
#pragma unroll
    for (int i = 0; i < 2; ++i) { int R, C; stage_rc(tid * 16 + i * 8192, R, C); const int Rb = Epi::PERM ? ((R & ~31) + perm32(R & 31)) : R;
        voffA[i] = (unsigned)(R * K + C) * 2u; voffB[i] = (unsigned)(Rb * K + C) * 2u; }
    const size_t kstep = (size_t)(BK * 2);
    const size_t hstep = (size_t)HALF * K * 2;
    const size_t tstep = 2 * hstep;
    const unsigned ldsw = (unsigned)wid * 1024u;
    const int aoff = lds_byte(wr * 64 + fr, fq * 8), boff = lds_byte(wc * 32 + fr, fq * 8);
#define PG8_SA(b, h) (((b) * 2 + (h)) * HTB)
#define PG8_SB(b, h) ((4 + (b) * 2 + (h)) * HTB)
#define PG8_STAGE(bufoff, gbase, voff) do { _Pragma("unroll") for (int _i = 0; _i < 2; ++_i) \
        __builtin_amdgcn_global_load_lds((const unsigned*)((const char*)(gbase) + (voff)[_i]), (PG8_LAS unsigned*)(lds + (bufoff) + ldsw + _i * 8192), 16, 0, 0); } while (0)
#define PG8_LDA(dst, b, h) do { _Pragma("unroll") for (int m = 0; m < 4; ++m) _Pragma("unroll") for (int k = 0; k < 2; ++k) dst[m][k] = *(const PG8_LAS bf16x8*)(lds + PG8_SA(b, h) + aoff + m * 2048 + k * 1024); } while (0)
#define PG8_LDB(dst, b, h) do { _Pragma("unroll") for (int n = 0; n < 2; ++n) _Pragma("unroll") for (int k = 0; k < 2; ++k) dst[n][k] = *(const PG8_LAS bf16x8*)(lds + PG8_SB(b, h) + boff + n * 2048 + k * 1024); } while (0)
#define PG8_MMA(ai, bj, At, Bt) do { __builtin_amdgcn_s_setprio(1); _Pragma("unroll") for (int m = 0; m < 4; ++m) _Pragma("unroll") for (int n = 0; n < 2; ++n) _Pragma("unroll") for (int k = 0; k < 2; ++k) \
        acc[ai][bj][m][n] = __builtin_amdgcn_mfma_f32_16x16x32_bf16(Bt[n][k], At[m][k], acc[ai][bj][m][n], 0, 0, 0); __builtin_amdgcn_s_setprio(0); } while (0)
#define PG8_WAIT_V(n) asm volatile("s_waitcnt vmcnt(" #n ")" ::: "memory")
#define PG8_WAIT_L(n) asm volatile("s_waitcnt lgkmcnt(" #n ")" ::: "memory")
#define PG8_BAR __builtin_amdgcn_s_barrier()
#define PG8_SCHED __builtin_amdgcn_sched_barrier(0)
    Unit cur, nxt; int ui = 0;
    if (!S.next(0, cur)) return;
    f32x4 acc[2][2][4][2];
#pragma unroll
    for (int a = 0; a < 2; ++a)
#pragma unroll
        for (int b = 0; b < 2; ++b)
#pragma unroll
            for (int m = 0; m < 4; ++m)
#pragma unroll
                for (int n = 0; n < 2; ++n) acc[a][b][m][n] = (f32x4){0.f, 0.f, 0.f, 0.f};
    bf16x8 At[4][2], B0[2][2], B1[2][2];
    const char* cA = (const char*)g.A + (size_t)cur.pm * tstep; const char* cB = (const char*)g.Bt + (size_t)cur.pn * tstep;
    S.a_ready(cur);
    if constexpr (SP2) {
        PG8_STAGE(PG8_SB(0, 0), cB, voffB); PG8_STAGE(PG8_SB(0, 1), cB + hstep, voffB); PG8_STAGE(PG8_SA(0, 0), cA, voffA); PG8_STAGE(PG8_SA(0, 1), cA + hstep, voffA);
        if (wr == 1) PG8_BAR;
        PG8_WAIT_V(2); PG8_BAR;
        PG8_STAGE(PG8_SB(1, 0), cB + kstep, voffB); PG8_STAGE(PG8_SA(1, 0), cA + kstep, voffA); PG8_STAGE(PG8_SB(1, 1), cB + hstep + kstep, voffB);
        PG8_WAIT_V(6); PG8_BAR;
    } else {
        PG8_STAGE(PG8_SB(0, 0), cB, voffB); PG8_STAGE(PG8_SA(0, 0), cA, voffA); PG8_STAGE(PG8_SB(0, 1), cB + hstep, voffB); PG8_STAGE(PG8_SA(0, 1), cA + hstep, voffA);
        if (wr == 1) PG8_BAR;
        PG8_WAIT_V(4); PG8_BAR;
        PG8_STAGE(PG8_SB(1, 0), cB + kstep, voffB); PG8_STAGE(PG8_SA(1, 0), cA + kstep, voffA); PG8_STAGE(PG8_SB(1, 1), cB + hstep + kstep, voffB);
        PG8_WAIT_V(6); PG8_BAR;
    }
    for (;;) {
        const bool has_next = S.next(ui + 1, nxt);
        const char* nA = has_next ? (const char*)g.A + (size_t)nxt.pm * tstep : cA; const char* nB = has_next ? (const char*)g.Bt + (size_t)nxt.pn * tstep : cB;
        for (int t = 0; t < nt; t += 2) {
            if constexpr (Epi::MID_K >= 0) { if (t == Epi::MID_K) E.mid(acc, cur, wr, wc, fr, fq); }
            const bool last = (t == nt - 2);
            const char* a1 = cA + (size_t)(t + 1) * kstep;
            const char* a2 = last ? nA : cA + (size_t)(t + 2) * kstep; const char* b2 = last ? nB : cB + (size_t)(t + 2) * kstep;
            const char* a3 = a2 + kstep; const char* b3 = b2 + kstep;
            if (last && has_next) S.a_ready(nxt);
            if constexpr (SP2) {
            PG8_LDB(B0, 0, 0); PG8_LDB(B1, 0, 1); PG8_SCHED; PG8_LDA(At, 0, 0); PG8_STAGE(PG8_SA(1, 1), a1 + hstep, voffA);
            PG8_WAIT_V(8); PG8_WAIT_L(0); PG8_BAR; PG8_MMA(0, 0, At, B0); PG8_MMA(0, 1, At, B1); PG8_BAR; PG8_SCHED;
            PG8_LDA(At, 0, 1); PG8_STAGE(PG8_SB(0, 0), b2, voffB); PG8_STAGE(PG8_SB(0, 1), b2 + hstep, voffB); PG8_STAGE(PG8_SA(0, 0), a2, voffA);
            PG8_WAIT_V(8); PG8_WAIT_L(0); PG8_BAR; PG8_MMA(1, 0, At, B0); PG8_MMA(1, 1, At, B1); PG8_BAR; PG8_SCHED;
            PG8_LDB(B0, 1, 0); PG8_LDB(B1, 1, 1); PG8_SCHED; PG8_LDA(At, 1, 0); PG8_STAGE(PG8_SA(0, 1), a2 + hstep, voffA);
            PG8_WAIT_V(8); PG8_WAIT_L(0); PG8_BAR; PG8_MMA(0, 0, At, B0); PG8_MMA(0, 1, At, B1); PG8_BAR; PG8_SCHED;
            PG8_LDA(At, 1, 1); PG8_STAGE(PG8_SB(1, 0), b3, voffB); PG8_STAGE(PG8_SB(1, 1), b3 + hstep, voffB); PG8_STAGE(PG8_SA(1, 0), a3, voffA);
            PG8_WAIT_V(8); PG8_WAIT_L(0); PG8_BAR; PG8_MMA(1, 0, At, B0); PG8_MMA(1, 1, At, B1); PG8_BAR; PG8_SCHED;
            } else {
            PG8_LDB(B0, 0, 0); PG8_SCHED; PG8_LDA(At, 0, 0); PG8_STAGE(PG8_SA(1, 1), a1 + hstep, voffA);
            PG8_WAIT_L(8); PG8_BAR; PG8_WAIT_L(0); PG8_MMA(0, 0, At, B0); PG8_BAR; PG8_SCHED;
            PG8_LDB(B1, 0, 1); PG8_STAGE(PG8_SB(0, 0), b2, voffB);
            PG8_BAR; PG8_WAIT_L(0); PG8_MMA(0, 1, At, B1); PG8_BAR;
            PG8_LDA(At, 0, 1); PG8_STAGE(PG8_SA(0, 0), a2, voffA);
            PG8_BAR; PG8_WAIT_L(0); PG8_MMA(1, 0, At, B0); PG8_BAR; PG8_SCHED;
            PG8_STAGE(PG8_SB(0, 1), b2 + hstep, voffB);
            PG8_WAIT_V(6); PG8_BAR; PG8_MMA(1, 1, At, B1); PG8_BAR;
            PG8_LDB(B0, 1, 0); PG8_SCHED; PG8_LDA(At, 1, 0); PG8_STAGE(PG8_SA(0, 1), a2 + hstep, voffA);
            PG8_WAIT_L(8); PG8_BAR; PG8_WAIT_L(0); PG8_MMA(0, 0, At, B0); PG8_BAR; PG8_SCHED;
            PG8_LDB(B1, 1, 1); PG8_STAGE(PG8_SB(1, 0), b3, voffB);
            PG8_BAR; PG8_WAIT_L(0); PG8_MMA(0, 1, At, B1); PG8_BAR;
            PG8_LDA(At, 1, 1); PG8_STAGE(PG8_SA(1, 0), a3, voffA);
            PG8_BAR; PG8_WAIT_L(0); PG8_MMA(1, 0, At, B0); PG8_BAR; PG8_SCHED;
            PG8_STAGE(PG8_SB(1, 1), b3 + hstep, voffB);
            PG8_WAIT_V(6); PG8_BAR; PG8_MMA(1, 1, At, B1); PG8_BAR;
            }
        }
        if constexpr (ALIGN_EPI) { if (wr == 0) PG8_BAR; }
        if constexpr (!Epi::AFTER_DRAIN) { E(acc, cur, wr, wc, fr, fq); S.done(cur); }
        if (!has_next) break;
#pragma unroll
        for (int a = 0; a < 2; ++a)
#pragma unroll
            for (int b = 0; b < 2; ++b)
#pragma unroll
                for (int m = 0; m < 4; ++m)
#pragma unroll
                    for (int n = 0; n < 2; ++n) acc[a][b][m][n] = (f32x4){0.f, 0.f, 0.f, 0.f};
        cur = nxt; cA = nA; cB = nB; ++ui;
        if constexpr (ALIGN_EPI) { if (wr == 1) PG8_BAR; }
    }
    PG8_WAIT_V(0);
    if constexpr (!ALIGN_EPI) { if (wr == 0) PG8_BAR; }
    PG8_BAR;
    if constexpr (Epi::AFTER_DRAIN) { E.fused(acc, cur, wr, wc, fr, fq, lds, wid, lane); S.done(cur); }
#undef PG8_SA
#undef PG8_SB
#undef PG8_STAGE
#undef PG8_LDA
#undef PG8_LDB
#undef PG8_MMA
#undef PG8_WAIT_V
#undef PG8_WAIT_L
#undef PG8_BAR
#undef PG8_SCHED
}
}

namespace att {
using bf16x8 = __attribute__((ext_vector_type(8))) short;
using s16x4  = __attribute__((ext_vector_type(4))) short;
using f32x16 = __attribute__((ext_vector_type(16))) float;
using u32x4  = __attribute__((ext_vector_type(4))) unsigned;
using i32x4  = __attribute__((ext_vector_type(4))) int;
typedef unsigned short bf16_t;
constexpr int NW = 8, QBLK = 32, KVBLK = 64, NT = SEQ / KVBLK, LDP = 512, LDO = 1536;
#ifndef ATT_SDEPTH
#define ATT_SDEPTH 1
#endif
constexpr int SDEPTH = ATT_SDEPTH;
constexpr float THR = 8.f;
constexpr int SHM_V = KVBLK * VD * 2, SHM_K = KVBLK * HD * 2;
constexpr int L_V = 0, L_K = 2 * SHM_V, L_WS = L_K + 2 * SHM_K, L_ST = L_WS + NW * 256, L_KP = L_ST + NW * 8192, L_LUT = L_KP + SEQ * 4, L_MM = L_LUT + 1280, L_END = L_MM + 256;
static_assert(L_END <= 131072, "attention LDS map");
#define ATT_KS(row, ch) ((row) * 128 + ((((ch) ^ (((row) >> 1) & 7))) << 4))
#define ATT_SBAR() __builtin_amdgcn_sched_barrier(0)
__device__ __forceinline__ int crow(int r, int hi) { return (r & 3) + 8 * (r >> 2) + 4 * hi; }
__device__ __forceinline__ unsigned cvtpk(float lo, float hi) { unsigned r; asm volatile("v_cvt_pk_bf16_f32 %0, %1, %2" : "=v"(r) : "v"(lo), "v"(hi)); return r; }

__device__ __forceinline__ void partialSM(f32x16& p0, f32x16& p1, float c, float& m_reg, float& alpha) {
  float pmax = p0[0];
#pragma unroll
  for (int r = 1; r < 16; ++r) pmax = fmaxf(pmax, p0[r]);
#pragma unroll
  for (int r = 0; r < 16; ++r) pmax = fmaxf(pmax, p1[r]);
  { auto rr = __builtin_amdgcn_permlane32_swap(__float_as_uint(pmax), __float_as_uint(pmax), false, false);
    pmax = fmaxf(__uint_as_float(rr[0]), __uint_as_float(rr[1])); }
  pmax += c;
  float mn;
  if (__builtin_expect(__all(pmax - m_reg <= THR), 1)) { mn = m_reg; alpha = 1.f; }
  else { mn = fmaxf(m_reg, pmax); alpha = __builtin_amdgcn_exp2f(m_reg - mn); m_reg = mn; }
  const float sub = mn - c;
#pragma unroll
  for (int r = 0; r < 16; ++r) { p0[r] -= sub; p1[r] -= sub; }
#pragma unroll
  for (int r = 0; r < 16; ++r) p0[r] = __builtin_amdgcn_exp2f(p0[r]);
}
__device__ __forceinline__ void finishSM(f32x16& p0, f32x16& p1, float alpha, float& l_reg, bf16x8& pa0, bf16x8& pa1, bf16x8& pa2, bf16x8& pa3) {
#pragma unroll
  for (int r = 0; r < 16; ++r) p1[r] = __builtin_amdgcn_exp2f(p1[r]);
  float ps = 0;
#pragma unroll
  for (int r = 0; r < 16; ++r) ps += p0[r];
#pragma unroll
  for (int r = 0; r < 16; ++r) ps += p1[r];
  { auto rr = __builtin_amdgcn_permlane32_swap(__float_as_uint(ps), __float_as_uint(ps), false, false);
    ps = __uint_as_float(rr[0]) + __uint_as_float(rr[1]); }
  l_reg = l_reg * alpha + ps;
#define ATT_PK4(P, BASE, OUT) do { unsigned a0 = cvtpk(P[BASE + 0], P[BASE + 1]), a1 = cvtpk(P[BASE + 2], P[BASE + 3]);   \
    unsigned b0 = cvtpk(P[BASE + 4], P[BASE + 5]), b1 = cvtpk(P[BASE + 6], P[BASE + 7]);                              \
    auto r0 = __builtin_amdgcn_permlane32_swap(a0, b0, false, false); auto r1 = __builtin_amdgcn_permlane32_swap(a1, b1, false, false); \
    u32x4 w = {r0[0], r1[0], r0[1], r1[1]}; OUT = *reinterpret_cast<bf16x8*>(&w); } while (0)
  ATT_PK4(p0, 0, pa0); ATT_PK4(p0, 8, pa1); ATT_PK4(p1, 0, pa2); ATT_PK4(p1, 8, pa3);
#undef ATT_PK4
}
__device__ __forceinline__ void qkt(f32x16& p0, f32x16& p1, const char* Ks, const bf16x8* qr, int r32, int hi) {
  p0 = f32x16{}; p1 = f32x16{};
#pragma unroll
  for (int d0 = 0; d0 < 4; ++d0) { const int ch = d0 * 2 + hi;
    const bf16x8 b0 = *reinterpret_cast<const bf16x8*>(Ks + ATT_KS(r32, ch));
    const bf16x8 b1 = *reinterpret_cast<const bf16x8*>(Ks + ATT_KS(r32, ch) + 4096);
    p0 = __builtin_amdgcn_mfma_f32_32x32x16_bf16(b0, qr[d0], p0, 0, 0, 0);
    p1 = __builtin_amdgcn_mfma_f32_32x32x16_bf16(b1, qr[d0], p1, 0, 0, 0); }
}
__device__ __forceinline__ void add_bias(f32x16& p0, f32x16& p1, const int* kp, const float* lut, int qp, int hi) {
#pragma unroll
  for (int g = 0; g < 4; ++g) {
    const i32x4 ka = *reinterpret_cast<const i32x4*>(kp + 8 * g + 4 * hi), kb = *reinterpret_cast<const i32x4*>(kp + 32 + 8 * g + 4 * hi);
#pragma unroll
    for (int e = 0; e < 4; ++e) {
      int ia = ka[e] - qp; ia = ia < -128 ? -128 : ia; ia = ia > 128 ? 128 : ia;
      int ib = kb[e] - qp; ib = ib < -128 ? -128 : ib; ib = ib > 128 ? 128 : ib;
      p0[4 * g + e] += lut[ia + 128]; p1[4 * g + e] += lut[ib + 128]; }
    ATT_SBAR(); }
}
__device__ __forceinline__ int v_st(int k, int c) { const int kk = (k & ~0xC) | ((k & 4) << 1) | ((k & 8) >> 1); return ((kk >> 3) * 4 + (c >> 5)) * 512 + ((kk & 7) * 32 + (c & 31)) * 2; }
__device__ __forceinline__ int v_rd_base(int lane) { return ((lane & 3) << 3) | (((lane >> 2) & 3) << 6) | (((lane >> 4) & 1) << 5) | (((lane >> 5) & 1) << 8); }
constexpr int v_rd_off(int d0, int ks, int half) { return d0 * 512 + ks * 4096 + half * 2048; }
template <int OFF> __device__ __forceinline__ s16x4 tr_read(int vb) {
  s16x4 r; asm volatile("ds_read_b64_tr_b16 %0, %1 offset:%2" : "=&v"(r) : "v"(vb), "i"(OFF) : "memory"); return r;
}
template <int D0> __device__ __forceinline__ void pv_one(f32x16& od, int vb, bf16x8 pa0, bf16x8 pa1, bf16x8 pa2, bf16x8 pa3) {
  const s16x4 l0 = tr_read<v_rd_off(D0, 0, 0)>(vb), h0 = tr_read<v_rd_off(D0, 0, 1)>(vb), l1 = tr_read<v_rd_off(D0, 1, 0)>(vb), h1 = tr_read<v_rd_off(D0, 1, 1)>(vb);
  const s16x4 l2 = tr_read<v_rd_off(D0, 2, 0)>(vb), h2 = tr_read<v_rd_off(D0, 2, 1)>(vb), l3 = tr_read<v_rd_off(D0, 3, 0)>(vb), h3 = tr_read<v_rd_off(D0, 3, 1)>(vb);
  asm volatile("s_waitcnt lgkmcnt(0)" ::: "memory"); ATT_SBAR();
#define ATT_PK(L, H) (bf16x8){L[0], L[1], L[2], L[3], H[0], H[1], H[2], H[3]}
  od = __builtin_amdgcn_mfma_f32_32x32x16_bf16(pa0, ATT_PK(l0, h0), od, 0, 0, 0);
  od = __builtin_amdgcn_mfma_f32_32x32x16_bf16(pa1, ATT_PK(l1, h1), od, 0, 0, 0);
  od = __builtin_amdgcn_mfma_f32_32x32x16_bf16(pa2, ATT_PK(l2, h2), od, 0, 0, 0);
  od = __builtin_amdgcn_mfma_f32_32x32x16_bf16(pa3, ATT_PK(l3, h3), od, 0, 0, 0);
#undef ATT_PK
}
__device__ __forceinline__ void pv_d0(f32x16* o, int vb, bf16x8 pa0, bf16x8 pa1, bf16x8 pa2, bf16x8 pa3) {
  pv_one<0>(o[0], vb, pa0, pa1, pa2, pa3); pv_one<1>(o[1], vb, pa0, pa1, pa2, pa3); pv_one<2>(o[2], vb, pa0, pa1, pa2, pa3); pv_one<3>(o[3], vb, pa0, pa1, pa2, pa3);
}

struct Tensors { const bf16_t* Q; const bf16_t* K; const bf16_t* V; bf16_t* O; const int* pos; const float* rel_bias; const float* subln_g; float lam; };

__device__ __forceinline__ void attn_unit(const Tensors& T, int b, int h, int qb, char* lds) {
  int tid_ = threadIdx.x; asm volatile("" : "+v"(tid_));
  const int tid = tid_, wid = __builtin_amdgcn_readfirstlane(tid >> 6), lane = tid & 63, r32 = lane & 31, hi = lane >> 5;
  char* V_lds = lds + L_V; char* K_lds = lds + L_K;
  float* ws = (float*)(lds + L_WS) + wid * 64; float* li_l = ws; float* al_l = ws + 32;
  unsigned* stash = (unsigned*)(lds + L_ST) + wid * 2048;
  int* kpos = (int*)(lds + L_KP); float* lut = (float*)(lds + L_LUT); int* kmm = (int*)(lds + L_MM);
  const long rowbase = (long)b * SEQ;
  { const i32x4 pv4 = *reinterpret_cast<const i32x4*>(T.pos + rowbase + tid * 4); *reinterpret_cast<i32x4*>(kpos + tid * 4) = pv4; }
  if (tid < 257) { const int rel = tid - 128, n = rel < 0 ? -rel : rel;
    int bk = n < 8 ? n : (n < 12 ? 8 : (n < 16 ? 9 : (n < 23 ? 10 : (n < 32 ? 11 : (n < 46 ? 12 : (n < 64 ? 13 : (n < 91 ? 14 : 15)))))));
    if (rel > 0) bk += 16;
    lut[tid] = T.rel_bias[bk * NH + h] * LOG2E; }
  __syncthreads();
#pragma unroll
  for (int i = 0; i < 4; ++i) { const int t = wid * 4 + i; int v = kpos[t * 64 + lane], mn = v, mx = v;
#pragma unroll
    for (int o = 1; o < 64; o <<= 1) { mn = min(mn, __shfl_xor(mn, o)); mx = max(mx, __shfl_xor(mx, o)); }
    if (lane == 0) { kmm[t] = mn; kmm[32 + t] = mx; } }
  const int q0 = qb * (QBLK * NW) + wid * QBLK;
  const int qp = kpos[q0 + r32];
  int qmin = qp, qmax = qp;
#pragma unroll
  for (int o = 1; o < 32; o <<= 1) { qmin = min(qmin, __shfl_xor(qmin, o)); qmax = max(qmax, __shfl_xor(qmax, o)); }
  qmin = __builtin_amdgcn_readfirstlane(qmin); qmax = __builtin_amdgcn_readfirstlane(qmax);
  const float cL = T.rel_bias[15 * NH + h] * LOG2E, cR = T.rel_bias[31 * NH + h] * LOG2E;
  __syncthreads();
#define ATT_CLASS(t, NEAR, C) do { const int kmn_ = kmm[(t)], kmx_ = kmm[32 + (t)]; \
    if (kmn_ - qmax >= 128) { NEAR = false; C = cR; } else if (kmx_ - qmin <= -128) { NEAR = false; C = cL; } else { NEAR = true; C = 0.f; } } while (0)
#if defined(ATT_VARIANT) && (ATT_VARIANT & 1)
#define ATT_BIAS(P0, P1, t, C) do { C = 0.f; } while (0)
#else
#define ATT_BIAS(P0, P1, t, C) do { bool near_; ATT_CLASS(t, near_, C); if (near_) add_bias(P0, P1, kpos + (t) * KVBLK, lut, qp, hi); } while (0)
#endif

  const bf16_t* Vh = T.V + rowbase * LDP + h * VD;

#pragma nounroll
#if defined(ATT_VARIANT) && (ATT_VARIANT & 4)
  for (int map = 0; map < 1; ++map) {
#else
  for (int map = 0; map < 2; ++map) {
#endif
    int tm_ = tid; asm volatile("" : "+v"(tm_));
    const int tid = tm_, lane = tid & 63, r32 = lane & 31, hi = lane >> 5;
    const int sr = tid >> 4, sc = (tid & 15) * 8, vst0 = v_st(sr, sc), vst1 = v_st(32 + sr, sc);
    const int kr = tid >> 3, kch = tid & 7, kst = ATT_KS(kr, kch);
    const int vb0 = (int)(uintptr_t)V_lds + v_rd_base(lane);
    const unsigned voff = (unsigned)(sr * LDP + sc) * 2u, koff = (unsigned)(kr * LDP + kch * 8) * 2u;
    const bf16_t* Kh = T.K + rowbase * LDP + h * (2 * HD) + map * HD;
    const bf16_t* Qw = T.Q + (rowbase + q0 + r32) * LDP + h * (2 * HD) + map * HD + hi * 8;
    float m_reg = -1e30f, l_reg = 0; f32x16 o[4] = {}; bf16x8 qr[4];
#pragma unroll
    for (int d0 = 0; d0 < 4; ++d0) qr[d0] = *reinterpret_cast<const bf16x8*>(Qw + d0 * 16);
    struct { bf16x8 vs0, vs1, ks0; } sr_[SDEPTH];
#define SLOAD(i, k0) do { const char* Vt_ = (const char*)Vh + (size_t)(k0) * (LDP * 2); const char* Kt_ = (const char*)Kh + (size_t)(k0) * (LDP * 2); \
      sr_[i].vs0 = *reinterpret_cast<const bf16x8*>(Vt_ + voff); sr_[i].vs1 = *reinterpret_cast<const bf16x8*>(Vt_ + 32 * LDP * 2 + voff); \
      sr_[i].ks0 = *reinterpret_cast<const bf16x8*>(Kt_ + koff); } while (0)
#define SWRITE(bf, i) do { *(bf16x8*)(V_lds + (bf) * SHM_V + vst0) = sr_[i].vs0; *(bf16x8*)(V_lds + (bf) * SHM_V + vst1) = sr_[i].vs1; \
      *(bf16x8*)(K_lds + (bf) * SHM_K + kst) = sr_[i].ks0; } while (0)
#define SWAIT() do { if constexpr (SDEPTH == 2) asm volatile("s_waitcnt vmcnt(3)" ::: "memory"); else asm volatile("s_waitcnt vmcnt(0)" ::: "memory"); } while (0)
#define RESC(a) do { if (__any((a) < 1.f)) { if (hi == 0) al_l[r32] = (a); asm volatile("s_waitcnt lgkmcnt(0)" ::: "memory"); \
      _Pragma("unroll") for (int d = 0; d < 4; ++d) _Pragma("unroll") for (int r = 0; r < 16; ++r) o[d][r] *= al_l[crow(r, hi)]; } } while (0)
    f32x16 pA0, pA1, pB0, pB1; float alA, alB, cA, cB; bf16x8 pa0, pa1, pa2, pa3;
    constexpr int SE = 0, SO = SDEPTH - 1;
    SLOAD(SE, 0); asm volatile("s_waitcnt vmcnt(0)" ::: "memory"); SWRITE(0, SE); __syncthreads();
    qkt(pA0, pA1, K_lds, qr, r32, hi); ATT_BIAS(pA0, pA1, 0, cA); partialSM(pA0, pA1, cA, m_reg, alA);
    SLOAD(SO, KVBLK); if constexpr (SDEPTH == 2) SLOAD(SE, 2 * KVBLK);
    SWAIT(); SWRITE(1, SO); __syncthreads();
    for (int j = 1; j + 1 < NT; j += 2) {
      ATT_SBAR(); qkt(pB0, pB1, K_lds + SHM_K, qr, r32, hi);
      finishSM(pA0, pA1, alA, l_reg, pa0, pa1, pa2, pa3); ATT_SBAR();
      SLOAD(SO, (j + SDEPTH) * KVBLK); ATT_SBAR();
      pv_d0(o, vb0, pa0, pa1, pa2, pa3); ATT_BIAS(pB0, pB1, j, cB); partialSM(pB0, pB1, cB, m_reg, alB);
      __syncthreads(); SWAIT(); SWRITE(0, SE);
      RESC(alB); __syncthreads();
      ATT_SBAR(); qkt(pA0, pA1, K_lds, qr, r32, hi);
      finishSM(pB0, pB1, alB, l_reg, pa0, pa1, pa2, pa3); ATT_SBAR();
      if (SDEPTH == 1 || j + 3 < NT) SLOAD(SE, (j + 1 + SDEPTH) * KVBLK); ATT_SBAR();
      pv_d0(o, vb0 + SHM_V, pa0, pa1, pa2, pa3); ATT_BIAS(pA0, pA1, j + 1, cA); partialSM(pA0, pA1, cA, m_reg, alA);
      __syncthreads(); SWAIT(); SWRITE(1, SO);
      RESC(alA); __syncthreads();
    }
    ATT_SBAR(); qkt(pB0, pB1, K_lds + SHM_K, qr, r32, hi);
    finishSM(pA0, pA1, alA, l_reg, pa0, pa1, pa2, pa3); ATT_SBAR();
    pv_d0(o, vb0, pa0, pa1, pa2, pa3); ATT_BIAS(pB0, pB1, NT - 1, cB); partialSM(pB0, pB1, cB, m_reg, alB);
    __syncthreads(); RESC(alB);
    finishSM(pB0, pB1, alB, l_reg, pa0, pa1, pa2, pa3); ATT_SBAR();
    pv_d0(o, vb0 + SHM_V, pa0, pa1, pa2, pa3);
#undef SLOAD
#undef SWRITE
#undef SWAIT
#undef RESC
    int lane_e = lane; asm volatile("" : "+v"(lane_e));
    const int r32e = lane_e & 31, hie = lane_e >> 5;
    if (hie == 0) li_l[r32e] = l_reg; asm volatile("s_waitcnt lgkmcnt(0)" ::: "memory");
    float rli[16];
#pragma unroll
    for (int r = 0; r < 16; ++r) rli[r] = __builtin_amdgcn_rcpf(li_l[crow(r, hie)]);
    unsigned* stl = stash + lane_e;
#if defined(ATT_VARIANT) && (ATT_VARIANT & 2)
    if (true) {
#else
    if (map == 0) {
#endif
#pragma unroll
      for (int d0 = 0; d0 < 4; ++d0)
#pragma unroll
        for (int r = 0; r < 16; r += 2) stl[(d0 * 8 + (r >> 1)) * 64] = cvtpk(o[d0][r] * rli[r], o[d0][r + 1] * rli[r + 1]);
    } else {
      const float lam = T.lam;
      float ssq[16];
#pragma unroll
      for (int r = 0; r < 16; ++r) ssq[r] = 0.f;
#pragma unroll
      for (int d0 = 0; d0 < 4; ++d0)
#pragma unroll
        for (int r = 0; r < 16; r += 2) { const unsigned w = stl[(d0 * 8 + (r >> 1)) * 64];
          const float a0 = __uint_as_float(w << 16) - lam * (o[d0][r] * rli[r]), a1 = __uint_as_float(w & 0xffff0000u) - lam * (o[d0][r + 1] * rli[r + 1]);
          o[d0][r] = a0; o[d0][r + 1] = a1; ssq[r] += a0 * a0; ssq[r + 1] += a1 * a1; }
#pragma unroll
      for (int r = 0; r < 16; ++r) {
        float v = ssq[r];
        v += __int_as_float(__builtin_amdgcn_ds_swizzle(__float_as_int(v), (1 << 10) | 0x1f));
        v += __int_as_float(__builtin_amdgcn_ds_swizzle(__float_as_int(v), (2 << 10) | 0x1f));
        v += __int_as_float(__builtin_amdgcn_ds_swizzle(__float_as_int(v), (4 << 10) | 0x1f));
        v += __int_as_float(__builtin_amdgcn_ds_swizzle(__float_as_int(v), (8 << 10) | 0x1f));
        v += __int_as_float(__builtin_amdgcn_ds_swizzle(__float_as_int(v), (16 << 10) | 0x1f));
        ssq[r] = rsqrtf(v * (1.0f / VD) + SUBLN_EPS) * (1.0f - LAMBDA_INIT); }
      float gs[4];
#pragma unroll
      for (int d0 = 0; d0 < 4; ++d0) gs[d0] = T.subln_g[d0 * 32 + r32e];
      bf16_t* Owl = T.O + (rowbase + q0 + 4 * hie) * LDO + h * VD + r32e;
#pragma unroll
      for (int r = 0; r < 16; ++r) { const int orow = (r & 3) + 8 * (r >> 2);
#pragma unroll
        for (int d0 = 0; d0 < 4; ++d0) { const float v = o[d0][r] * ssq[r] * gs[d0]; unsigned u = __builtin_bit_cast(unsigned, v); u = (u + 0x7fffu + ((u >> 16) & 1u)) >> 16;
          Owl[(long)orow * LDO + d0 * 32] = (bf16_t)u; } }
    }
    __syncthreads();
  }
#undef ATT_CLASS
#undef ATT_BIAS
}
#undef ATT_KS
#undef ATT_SBAR
}
#define GAS __attribute__((address_space(1)))
#define LAS __attribute__((address_space(3)))
typedef unsigned short bf16;
typedef unsigned v4u __attribute__((ext_vector_type(4)));
typedef float f32x4 __attribute__((ext_vector_type(4)));
typedef short bf16x8 __attribute__((ext_vector_type(8)));
typedef GAS unsigned gu32;
typedef GAS unsigned long long gu64;
#define RLX_AGENT __ATOMIC_RELAXED, __HIP_MEMORY_SCOPE_AGENT
#define LDS_WAIT() asm volatile("s_waitcnt lgkmcnt(0)" ::: "memory")
#define VM_WAIT() asm volatile("s_waitcnt vmcnt(0)" ::: "memory")
__device__ __forceinline__ unsigned long long rt() { return __builtin_amdgcn_s_memrealtime(); }
__device__ __forceinline__ unsigned f2bf(float f) { unsigned u = __builtin_bit_cast(unsigned, f); return (u + 0x7fffu + ((u >> 16) & 1u)) >> 16; }
__device__ __forceinline__ unsigned pk2(float lo, float hi) { return f2bf(lo) | (f2bf(hi) << 16); }

#define XB_TMO      128
#define XB_XCNT(j)  (256  + 64 * (j))
#define XB_XSUB(j)  (1280 + 64 * (j))
#define XB_XGEN(j)  (2304 + 64 * (j))
#define XB_TOP      3328
#define XB_TOPGEN   3392
#define XCD_BAR_WORDS 3456
#define XB_SPIN_CAP (1u << 18)

__device__ __forceinline__ unsigned xb_ld(unsigned* p)              { return __hip_atomic_load(p, __ATOMIC_RELAXED, __HIP_MEMORY_SCOPE_AGENT); }
__device__ __forceinline__ unsigned xb_add(unsigned* p, unsigned v) { return __hip_atomic_fetch_add(p, v, __ATOMIC_RELAXED, __HIP_MEMORY_SCOPE_AGENT); }
__device__ __forceinline__ unsigned xb_xcc_id() { return (unsigned)__builtin_amdgcn_s_getreg((3 << 11) | 20) & 0xFu; }
#define XB_SPIN(cond, bar) do { unsigned _sp = 0; while (cond) { __builtin_amdgcn_s_sleep(1); \
    if ((++_sp & 255u) == 0u) { if (xb_ld(&(bar)[XB_TMO])) break; if (_sp > XB_SPIN_CAP) { atomicAdd(&(bar)[XB_TMO], 1u); break; } } } } while (0)

struct XcdBarrier {
    unsigned* bar; unsigned x;
    volatile LAS unsigned* st;
};

__device__ __forceinline__ XcdBarrier xcd_barrier_post(unsigned* bar, volatile LAS unsigned* st) {
    XcdBarrier b; b.bar = bar; b.x = xb_xcc_id(); b.st = st;
    if (threadIdx.x == 0) (void)xb_add(&bar[XB_XCNT(b.x)], 1u);
    return b;
}
__device__ __forceinline__ void xcd_barrier_complete(unsigned* bar, unsigned x, unsigned& nloc, unsigned& nx) {
    const unsigned G = gridDim.x * gridDim.y * gridDim.z;
    unsigned sum, cnt, mine, sp = 0u;
    for (;;) {
        sum = 0u; cnt = 0u; mine = 0u;
#pragma unroll
        for (unsigned j = 0; j < 16; ++j) { const unsigned c = xb_ld(&bar[XB_XCNT(j)]); sum += c; cnt += (c > 0u) ? 1u : 0u; mine = (j == x) ? c : mine; }
        if (sum == G) break;
        __builtin_amdgcn_s_sleep(1);
        if ((++sp & 255u) == 0u) { if (xb_ld(&bar[XB_TMO])) break; if (sp > XB_SPIN_CAP) { atomicAdd(&bar[XB_TMO], 1u); break; } }
    }
    nloc = mine > 0u ? mine : 1u; nx = cnt > 0u ? cnt : 1u;
}

__device__ __forceinline__ void xcd_barrier(const XcdBarrier& b) {
    asm volatile("s_waitcnt vmcnt(0)" ::: "memory");
    __syncthreads();
    if (threadIdx.x == 0) {
        unsigned* bar = b.bar;
        __builtin_amdgcn_s_waitcnt(0);
        unsigned nloc = b.st[0], nx = b.st[1];
        if (nloc == 0u) { xcd_barrier_complete(bar, b.x, nloc, nx); b.st[0] = nloc; b.st[1] = nx; }
        const unsigned old = xb_add(&bar[XB_XSUB(b.x)], 1u);
        const unsigned gen = old / nloc;
        if (old + 1u == (gen + 1u) * nloc) {
            __builtin_amdgcn_fence(__ATOMIC_RELEASE, "agent");
            asm volatile("s_waitcnt vmcnt(0)" ::: "memory");
            const unsigned og = xb_add(&bar[XB_TOP], 1u);
            const unsigned tg = og / nx;
            if (og + 1u == (tg + 1u) * nx) xb_add(&bar[XB_TOPGEN], 1u);
            else XB_SPIN(xb_ld(&bar[XB_TOPGEN]) == tg, bar);
            __builtin_amdgcn_fence(__ATOMIC_ACQUIRE, "agent");
            xb_add(&bar[XB_XGEN(b.x)], 1u);
            asm volatile("s_waitcnt vmcnt(0)" ::: "memory");
        } else {
            XB_SPIN(xb_ld(&bar[XB_XGEN(b.x)]) == gen, bar);
            __builtin_amdgcn_fence(__ATOMIC_ACQUIRE, "agent");
            asm volatile("s_waitcnt vmcnt(0)" ::: "memory");
        }
    }
    __syncthreads();
}

constexpr int NWAVES = 8;
constexpr size_t MiB = (size_t)1 << 20, HM = (size_t)1 << 19;
constexpr size_t WS_CTL = 0, CTL_ZERO_BYTES = 64 * 1024;
constexpr size_t WS_SSQ = 1 * MiB, SSQ_BYTES = (size_t)M * 4 * 4;
constexpr size_t WS_WGU1 = 4 * HM, WS_WD1 = 26 * HM, WS_WIN = 37 * HM, WS_WCAT = 53 * HM, WS_WOUT = 59 * HM, WS_WGU2 = 63 * HM, WS_WD2 = 85 * HM, WS_DFT = 96 * HM;
constexpr size_t WS_XB = 64 * MiB;
constexpr size_t WS_R = 96 * MiB;
constexpr size_t WS_H = WS_R, WS_UT = WS_R, WS_Q = WS_R + 16 * MiB, WS_K = WS_R + 32 * MiB, WS_V = WS_R + 48 * MiB, WS_GA = WS_R + 64 * MiB, WS_GB = WS_R + 96 * MiB;
constexpr size_t WS_END = WS_R + 128 * MiB;
static_assert(WS_K - WS_Q == 16 * MiB && WS_V - WS_K == 16 * MiB && WS_GB - WS_GA == 32 * MiB, "EpiWin pointer strides");
static_assert(WS_END <= 256 * MiB && WS_DFT + 32 * HM == WS_XB && WS_H + (size_t)M * FF * 2 <= WS_END && (size_t)M * (D + FW) * 2 <= (size_t)M * D * 4, "d_ws map");
constexpr int CW_BAR = 4096;
constexpr int RING_BYTES = 131072, LDSCTL_OFF = RING_BYTES, MISC_OFF = LDSCTL_OFF + 320, PTR_OFF = LDSCTL_OFF + 1024, LDS_BYTES = 147456;
constexpr int CTL_LDS_WORDS = 256;

__device__ __forceinline__ float wave_sum(float v) {
#pragma unroll
    for (int o = 1; o < 64; o <<= 1) v += __shfl_xor(v, o);
    return v;
}
typedef float f32x2g __attribute__((ext_vector_type(2)));
__device__ __forceinline__ void p0_cvt_item(const float* W, int K, int N, bf16* WT, int ldt, const float* gain, int mode, int item, int lane) {
    const int kb32 = K / 32, nc = item / kb32, k0 = (item - nc * kb32) * 32, n = nc * 128 + 2 * lane;
    const int drow = mode == 0 ? n : (((n >> 7) << 8) + (n & 127) + (mode == 2 ? 128 : 0));
    const GAS f32x2g* src = (const GAS f32x2g*)(W + (size_t)k0 * N + n);
    f32x2g w[32];
#pragma unroll
    for (int i = 0; i < 32; ++i) w[i] = src[(size_t)i * (N / 2)];
    if (gain) {
#pragma unroll
        for (int i = 0; i < 32; ++i) { const float g = gain[k0 + i]; w[i] = w[i] * g; }
    }
    GAS v4u* d0 = (GAS v4u*)(WT + (size_t)drow * ldt + k0); GAS v4u* d1 = (GAS v4u*)(WT + (size_t)(drow + 1) * ldt + k0);
#pragma unroll
    for (int kb = 0; kb < 4; ++kb) {
        v4u a, b;
        a.x = pk2(w[8 * kb + 0].x, w[8 * kb + 1].x); a.y = pk2(w[8 * kb + 2].x, w[8 * kb + 3].x); a.z = pk2(w[8 * kb + 4].x, w[8 * kb + 5].x); a.w = pk2(w[8 * kb + 6].x, w[8 * kb + 7].x);
        b.x = pk2(w[8 * kb + 0].y, w[8 * kb + 1].y); b.y = pk2(w[8 * kb + 2].y, w[8 * kb + 3].y); b.z = pk2(w[8 * kb + 4].y, w[8 * kb + 5].y); b.w = pk2(w[8 * kb + 6].y, w[8 * kb + 7].y);
        d0[kb] = a; d1[kb] = b; }
}

#ifndef PHMASK
#define PHMASK 0xfff
#endif
#define PH(k) ((PHMASK >> (k)) & 1)
#ifndef PROBE_DUP
#define PROBE_DUP -1
#endif
#define REP(k) for (int rep_ = 0; rep_ < ((PROBE_DUP) == (k) ? 2 : 1); ++rep_)
__device__ __forceinline__ const GAS float* in_ptr(LAS unsigned char* L, int i) {
    const unsigned long long v = ((const LAS unsigned long long*)(L + PTR_OFF))[i];
    const unsigned lo = __builtin_amdgcn_readfirstlane((unsigned)v), hi = __builtin_amdgcn_readfirstlane((unsigned)(v >> 32));
    return (const GAS float*)(uintptr_t)(((unsigned long long)hi << 32) | lo);
}
#define INF(i) ((const float*)in_ptr(L, (i)))
struct Args { const void* in[22]; float* out; unsigned char* ws; };

__global__ void __launch_bounds__(NWAVES * 64, 2) enc_fwd(Args args) {
    extern __shared__ __attribute__((aligned(16))) unsigned char lds[];
    LAS unsigned char* L = (LAS unsigned char*)lds;
    volatile LAS unsigned* MISC = (volatile LAS unsigned*)(L + MISC_OFF);
    const int tid = threadIdx.x, lane = tid & 63, wave = __builtin_amdgcn_readfirstlane(tid >> 6);
    const int G = gridDim.x, bx = blockIdx.x, vcu = (G % 8 == 0) ? (bx % 8) * (G / 8) + bx / 8 : bx;
    unsigned char* ws = args.ws;
    gu32* ctl = (gu32*)(ws + WS_CTL);
    float* out = args.out;
    bf16 *WGU1 = (bf16*)(ws + WS_WGU1), *WD1 = (bf16*)(ws + WS_WD1), *WIN = (bf16*)(ws + WS_WIN), *WCAT = (bf16*)(ws + WS_WCAT), *WOUT = (bf16*)(ws + WS_WOUT);
    bf16 *WGU2 = (bf16*)(ws + WS_WGU2), *WD2 = (bf16*)(ws + WS_WD2), *DFTM = (bf16*)(ws + WS_DFT);
    bf16 *XB = (bf16*)(ws + WS_XB), *ACAT = (bf16*)out, *HB = (bf16*)(ws + WS_H), *UT = (bf16*)(ws + WS_UT), *QB = (bf16*)(ws + WS_Q), *KB = (bf16*)(ws + WS_K), *VB = (bf16*)(ws + WS_V);
    bf16 *GA = (bf16*)(ws + WS_GA), *GB = (bf16*)(ws + WS_GB);
    float *SSQ0 = (float*)(ws + WS_SSQ), *SSQ1 = SSQ0 + (size_t)M * 4, *SSQ2 = SSQ1 + (size_t)M * 4, *SSQ3 = SSQ2 + (size_t)M * 4;

    for (int u = tid; u < CTL_LDS_WORDS; u += NWAVES * 64) ((LAS unsigned*)(L + LDSCTL_OFF))[u] = 0u;
    if (tid < 22) ((LAS unsigned long long*)(L + PTR_OFF))[tid] = (unsigned long long)(uintptr_t)args.in[tid];
    __syncthreads();
    XcdBarrier bar = xcd_barrier_post((unsigned*)(ctl + CW_BAR), MISC + 8);
    const int gw = vcu * NWAVES + wave, NGW = G * NWAVES;

    if constexpr (PH(0)) {
        LAS float* trig = (LAS float*)(L + 0);
        LAS unsigned short* ctab = (LAS unsigned short*)(L + 1024);
        if (tid < 128) { float s, c; sincospif((float)tid * (1.0f / 64.0f), &s, &c); trig[tid] = c; trig[128 + tid] = s; }
#pragma unroll
        for (int i = 0; i < 4; ++i) { const int t = tid + i * (NWAVES * 64); ctab[t] = (unsigned short)f2bf(cospif((float)t * (1.0f / 1024.0f))); }
        __syncthreads();
        constexpr int I_GU = (D / 32) * (FF / 128), I_DN = (FF / 32) * (D / 128), I_IN = (D / 32) * (INW / 128), I_AO = (FW / 32) * (D / 128), I_OUT = (D / 32) * (D / 128);
        constexpr int NITEMS = 4 * I_GU + 2 * I_DN + I_IN + I_AO + I_OUT;
        for (int it = gw; it < NITEMS; it += NGW) {
            int r = it;
            if (r < I_GU) { p0_cvt_item(INF(4), D, FF, WGU1, D, INF(3), 1, r, lane); continue; } r -= I_GU;
            if (r < I_GU) { p0_cvt_item(INF(5), D, FF, WGU1, D, INF(3), 2, r, lane); continue; } r -= I_GU;
            if (r < I_GU) { p0_cvt_item(INF(18), D, FF, WGU2, D, INF(17), 1, r, lane); continue; } r -= I_GU;
            if (r < I_GU) { p0_cvt_item(INF(19), D, FF, WGU2, D, INF(17), 2, r, lane); continue; } r -= I_GU;
            if (r < I_DN) { p0_cvt_item(INF(6), FF, D, WD1, FF, nullptr, 0, r, lane); continue; } r -= I_DN;
            if (r < I_DN) { p0_cvt_item(INF(20), FF, D, WD2, FF, nullptr, 0, r, lane); continue; } r -= I_DN;
            if (r < I_IN) { p0_cvt_item(INF(8), D, INW, WIN, D, INF(7), 0, r, lane); continue; } r -= I_IN;
            if (r < I_AO) { p0_cvt_item(INF(15), FW, D, WCAT + 1024, 1536, nullptr, 0, r, lane); continue; } r -= I_AO;
            p0_cvt_item(INF(16), D, D, WOUT, D, nullptr, 0, r, lane);
        }
        for (int tile = gw; tile < 1024; tile += NGW) {
            const int g = tile >> 8, kt = (tile >> 5) & 7, nt = tile & 31, hi = lane >> 5, r32 = lane & 31;
            const bool iss = kt >= 4; const int c = (kt & 3) * 32 + r32;
            const LAS float* tb = trig + (iss ? 128 : 0);
            const float* wf = INF(14) + (size_t)(g * 128 + hi) * D + nt * 32 + r32;
            pg8::f32x4 dummy; (void)dummy;
            typedef float f32x16p __attribute__((ext_vector_type(16)));
            f32x16p acc = {};
#pragma unroll 8
            for (int s = 0; s < 64; ++s) { const int m = 2 * s + hi; acc = __builtin_amdgcn_mfma_f32_32x32x2f32(tb[(c * m) & 127], wf[(size_t)(2 * s) * D], acc, 0, 0, 0); }
            const float sc = iss ? -(1.0f / 512.0f) : (1.0f / 512.0f);
            bf16* dst = WCAT + (size_t)(nt * 32 + r32) * 1536 + (iss ? 512 : 0) + g * 128 + (kt & 3) * 32 + 4 * hi;
#pragma unroll
            for (int q = 0; q < 4; ++q) { unsigned long long w8 = (unsigned long long)pk2(acc[4 * q] * sc, acc[4 * q + 1] * sc) | ((unsigned long long)pk2(acc[4 * q + 2] * sc, acc[4 * q + 3] * sc) << 32);
                *(GAS unsigned long long*)(dst + 8 * q) = w8; }
        }
        for (int it = vcu * (NWAVES * 64) + tid; it < 4096 * 256; it += G * NWAVES * 64) {
            const int jr = it >> 8, s0 = (it & 255) * 8, jj = jr & 2047; int t = jj * s0 - (jr >= 2048 ? 512 : 0);
            unsigned v[8];
#pragma unroll
            for (int i = 0; i < 8; ++i) { v[i] = ctab[t & 2047]; t += jj; }
            v4u o; o.x = v[0] | (v[1] << 16); o.y = v[2] | (v[3] << 16); o.z = v[4] | (v[5] << 16); o.w = v[6] | (v[7] << 16);
            *(GAS v4u*)(DFTM + (size_t)jr * 2048 + s0) = o;
        }
        const float* xin = INF(0);
        for (int m = gw; m < M; m += NGW) {
            const GAS f32x4* xr = (const GAS f32x4*)(xin + (size_t)m * D) + lane; GAS unsigned long long* o8 = (GAS unsigned long long*)(XB + (size_t)m * D) + lane;
            float s = 0.f;
#pragma unroll
            for (int j = 0; j < 4; ++j) { const f32x4 v = xr[64 * j]; s += (v.x * v.x + v.y * v.y) + (v.z * v.z + v.w * v.w);
                o8[64 * j] = (unsigned long long)pk2(v.x, v.y) | ((unsigned long long)pk2(v.z, v.w) << 32); }
            s = wave_sum(s);
            if (lane == 0) *(GAS f32x4*)(SSQ0 + (size_t)m * 4) = (f32x4){s, 0.f, 0.f, 0.f};
        }
        __syncthreads();
    }
    xcd_barrier(bar);

#ifdef PROBE_XBAR
    for (int xb_ = 0; xb_ < PROBE_XBAR; ++xb_) xcd_barrier(bar);
#endif
#ifdef PROBE_XBAR_S
    xcd_barrier(bar);
#endif
    if constexpr (PH(1)) REP(1) { pg8::Gemm g{XB, WGU1, M, 2 * FF, D}; pg8::StaticOrder S; S.init(M, 2 * FF, G, bx);
      pg8::EpiSwiglu E{HB, SSQ0, FF};
      pg8::gemm_phase<pg8::EpiSwiglu, pg8::StaticOrder, true, true>(L, g, S, E); }
    xcd_barrier(bar);
#ifdef PROBE_UNITS2_P2
    if constexpr (PH(2)) { pg8::Gemm g{HB, WD1, M, D, FF}; pg8::TwiceOrder S; S.init(M, D, G, bx);
      pg8::EpiResid<false, false, true> E{INF(0), nullptr, XB, SSQ1, 0.5f, D};
      pg8::gemm_phase<pg8::EpiResid<false, false, true>, pg8::TwiceOrder, false, true>(L, g, S, E); }
#else
    if constexpr (PH(2)) REP(2) { pg8::Gemm g{HB, WD1, M, D, FF}; pg8::StaticOrder S; S.init(M, D, G, bx);
      pg8::EpiResid<false, false, true> E{INF(0), nullptr, XB, SSQ1, 0.5f, D};
      pg8::gemm_phase<pg8::EpiResid<false, false, true>, pg8::StaticOrder, false, true>(L, g, S, E); }
#endif
    xcd_barrier(bar);
#ifdef PROBE_UNITS2_P3
    if constexpr (PH(3)) { pg8::Gemm g{XB, WIN, M, INW, D}; pg8::TwiceOrder S; S.init(M, INW, G, bx);
      pg8::EpiWin E{SSQ1, UT, QB, GA, QSCALE};
      pg8::gemm_phase<pg8::EpiWin, pg8::TwiceOrder, true, true>(L, g, S, E); }
#else
    if constexpr (PH(3)) REP(3) { pg8::Gemm g{XB, WIN, M, INW, D}; pg8::StaticOrder S; S.init(M, INW, G, bx);
      pg8::EpiWin E{SSQ1, UT, QB, GA, QSCALE};
      pg8::gemm_phase<pg8::EpiWin, pg8::StaticOrder, true, true>(L, g, S, E);
#ifdef PROBE_BAR3
      if (rep_ == 0) xcd_barrier(bar);
#endif
    }
#endif
    xcd_barrier(bar);
    if constexpr (PH(4)) REP(4) { pg8::Gemm g{DFTM, UT, 4096, 4096, SEQ}; pg8::DftOrder S{vcu};
      pg8::EpiDft E{ACAT, 1536};
      pg8::gemm_phase<pg8::EpiDft, pg8::DftOrder, false, true>(L, g, S, E); }
    if constexpr (PH(10)) REP(10) {
        float d1 = INF(9)[lane] * INF(10)[lane], d2 = INF(11)[lane] * INF(12)[lane]; d1 = wave_sum(d1); d2 = wave_sum(d2);
        const float lam = __builtin_bit_cast(float, __builtin_amdgcn_readfirstlane(__builtin_bit_cast(int, expf(d1) - expf(d2) + LAMBDA_INIT)));
        att::Tensors T{QB, KB, VB, ACAT + 1024, (const int*)(const GAS int*)in_ptr(L, 1), INF(2), INF(13), lam};
        if (vcu < BATCH * NH * 8) { const int bh = vcu >> 3; att::attn_unit(T, bh >> 2, bh & 3, vcu & 7, (char*)lds); }
    }
    xcd_barrier(bar);
    if constexpr (PH(5)) { pg8::Gemm g{ACAT, WCAT, M, D, D + FW}; pg8::StaticOrder S; S.init(M, D, G, bx);
      pg8::EpiGate E{GA, GB};
      pg8::gemm_phase<pg8::EpiGate, pg8::StaticOrder, false, true>(L, g, S, E); }
    xcd_barrier(bar);
    if constexpr (PH(6)) REP(6) { pg8::Gemm g{GB, WOUT, M, D, D}; pg8::StaticOrder S; S.init(M, D, G, bx);
      pg8::EpiResid<true, false, true> E{XB, nullptr, XB, SSQ2, 1.0f, D};
      pg8::gemm_phase<pg8::EpiResid<true, false, true>, pg8::StaticOrder, false, true>(L, g, S, E); }
    xcd_barrier(bar);
    if constexpr (PH(7)) REP(7) { pg8::Gemm g{XB, WGU2, M, 2 * FF, D}; pg8::StaticOrder S; S.init(M, 2 * FF, G, bx);
      pg8::EpiSwiglu E{HB, SSQ2, FF};
      pg8::gemm_phase<pg8::EpiSwiglu, pg8::StaticOrder, true, true>(L, g, S, E); }
    xcd_barrier(bar);
    if constexpr (PH(8)) REP(8) { pg8::Gemm g{HB, WD2, M, D, FF}; pg8::StaticOrder S; S.init(M, D, G, bx);
      pg8::EpiResid<true, true, false> E{XB, out, nullptr, SSQ3, 0.5f, D};
      pg8::gemm_phase<pg8::EpiResid<true, true, false>, pg8::StaticOrder, false, true>(L, g, S, E); }
    xcd_barrier(bar);
#ifdef PROBE_EBAR
    for (int xb_ = 0; xb_ < PROBE_EBAR; ++xb_) xcd_barrier(bar);
#endif
    const float* nfgp = INF(21);
    if constexpr (PH(9)) for (int m = gw; m < M; m += NGW) {
        const f32x4 sq = *(const GAS f32x4*)(SSQ3 + (size_t)m * 4); const float rs = rsqrtf(((sq.x + sq.y) + (sq.z + sq.w)) * (1.0f / D) + NORM_EPS);
        GAS f32x4* xr = (GAS f32x4*)(out + (size_t)m * D) + lane; const GAS f32x4* gr = (const GAS f32x4*)nfgp + lane;
#pragma unroll
        for (int j = 0; j < 4; ++j) { const f32x4 v = xr[64 * j], gg = gr[64 * j]; xr[64 * j] = v * rs * gg; }
    }
}

extern "C" void kernel_launch(void* const* d_in, const int* in_sizes, int n_in, void* d_out, int out_size, void* d_ws, size_t ws_size, hipStream_t stream) {
    static int grid = 0;
    if (grid == 0) {
        if (n_in != 22 || in_sizes[0] != M * D || out_size != M * D || ws_size < WS_END) { fprintf(stderr, "kernel_launch: unexpected shapes (n_in %d, in0 %d, out %d, ws %zu); nothing launched\n", n_in, n_in > 0 ? in_sizes[0] : -1, out_size, ws_size); grid = -1; return; }
        int dev = 0, cus = 0, per_cu = 0;
        if (hipGetDevice(&dev) != hipSuccess || hipDeviceGetAttribute(&cus, hipDeviceAttributeMultiprocessorCount, dev) != hipSuccess) { fprintf(stderr, "kernel_launch: device query failed\n"); grid = -1; return; }
        if (hipFuncSetAttribute((const void*)enc_fwd, hipFuncAttributeMaxDynamicSharedMemorySize, LDS_BYTES) != hipSuccess) { fprintf(stderr, "kernel_launch: hipFuncSetAttribute failed\n"); grid = -1; return; }
        if (hipOccupancyMaxActiveBlocksPerMultiprocessor(&per_cu, (const void*)enc_fwd, NWAVES * 64, LDS_BYTES) != hipSuccess || per_cu < 1) { fprintf(stderr, "kernel_launch: occupancy query reports %d blocks per CU\n", per_cu); }
        (void)hipGetLastError();
        grid = 256;
        if (cus < 256) { fprintf(stderr, "kernel_launch: %d CUs < 256: the grid would not be resident; nothing launched\n", cus); grid = -1; return; }
    }
    if (grid < 0) return;
    if (hipMemsetAsync((char*)d_ws + WS_CTL, 0, CTL_ZERO_BYTES, stream) != hipSuccess) { fprintf(stderr, "kernel_launch: memset failed\n"); return; }
    Args a{};
    for (int i = 0; i < 22; ++i) a.in[i] = d_in[i];
    a.out = (float*)d_out; a.ws = (unsigned char*)d_ws;
    hipLaunchKernelGGL(enc_fwd, dim3(grid), dim3(NWAVES * 64), LDS_BYTES, stream, a);
    const hipError_t le = hipPeekAtLastError();
    if (le != hipSuccess) fprintf(stderr, "kernel_launch: launch failed: %s\n", hipGetErrorName(le));
}
```
